# Optimizing an MI355X kernel written in HIP

```python
import math
import jax
import jax.numpy as jnp
from jax import lax
import numpy as np

D_MODEL = 1024
BATCH = 2
SEQ = 16384
DEPTH = 2

PLE_DIM = 256
DN_ALPHA = (2.0 * DEPTH) ** 0.25
DN_BETA = (8.0 * DEPTH) ** -0.25
LN_EPS = 1e-5
HEAD_NORM_EPS = 1e-6
N_EVEN = (DEPTH + 1) // 2
N_ODD = DEPTH // 2

MOBA_HEADS = 8
MOBA_HEAD_DIM = 64
MOBA_BLOCK = 256
MOBA_TOPK = 3
MOBA_Q_BLOCK = 128
REL_BUCKETS = 32
REL_MAX_DIST = 128
GLA_HEADS = 4
GLA_DK = 64
GLA_DV = 128
GLA_GATE_RANK = 16
GLA_TAU = 16.0
HGRN_HEADS = 4
HGRN_DK = 64
HGRN_DV = 128
RET_HEADS = 4
RET_DK = 64
RET_DV = 128
ROPE_BASE = 10000.0
CHUNK = 64
FFN_DENSE = 2752
N_EXPERTS = 8
TOP_K = 2
FFN_EXPERT = 3584
MOE_BLOCK = 128

MOBA_W = MOBA_HEADS * MOBA_HEAD_DIM
EVEN_SPLITS = (MOBA_W, MOBA_W, MOBA_W,
               GLA_HEADS * GLA_DK, GLA_HEADS * GLA_DK, GLA_HEADS * GLA_DV,
               GLA_GATE_RANK, GLA_HEADS * GLA_DV)
ODD_SPLITS = (HGRN_HEADS * HGRN_DK, HGRN_HEADS * HGRN_DK, HGRN_HEADS * HGRN_DV, HGRN_HEADS * HGRN_DV,
              RET_HEADS * RET_DK, RET_HEADS * RET_DK, RET_HEADS * RET_DV, RET_HEADS * RET_DV)
EVEN_IN = sum(EVEN_SPLITS)
ODD_IN = sum(ODD_SPLITS)
EVEN_OUT = MOBA_W + GLA_HEADS * GLA_DV
ODD_OUT = HGRN_HEADS * HGRN_DV + RET_HEADS * RET_DV

kernel_name = 'hybrid_moba_gla_hgrn2_retnet_moe'


def split_cols(h, sizes):
    return jnp.split(h, [int(c) for c in np.cumsum(sizes)[:-1]], axis=-1)


def split_heads(t, n_heads):
    b, s, w = t.shape
    return t.reshape(b, s, n_heads, w // n_heads).transpose(0, 2, 1, 3)


def merge_heads(o):
    b, h, s, d = o.shape
    return o.transpose(0, 2, 1, 3).reshape(b, s, h * d)


def layer_norm(x, g, b):
    xf = x.astype(jnp.float32)
    xc = xf - jnp.mean(xf, axis=-1, keepdims=True)
    y = xc * lax.rsqrt(jnp.mean(xc * xc, axis=-1, keepdims=True) + LN_EPS)
    return (y * g.astype(jnp.float32) + b.astype(jnp.float32)).astype(x.dtype)


def head_rms_norm(o, g):
    o = o * lax.rsqrt(jnp.mean(o * o, axis=-1, keepdims=True) + HEAD_NORM_EPS)
    return merge_heads(o) * g.astype(jnp.float32)


def head_layer_norm(o, g):
    o = o - jnp.mean(o, axis=-1, keepdims=True)
    o = o * lax.rsqrt(jnp.mean(o * o, axis=-1, keepdims=True) + HEAD_NORM_EPS)
    return merge_heads(o) * g.astype(jnp.float32)


def t5_bucket(dist):
    n = jnp.maximum(dist, 0)
    max_exact = REL_BUCKETS // 2
    nf = jnp.maximum(n, 1).astype(jnp.float32)
    large = max_exact + (jnp.log(nf / max_exact) / math.log(REL_MAX_DIST / max_exact)
                         * (REL_BUCKETS - max_exact)).astype(jnp.int32)
    large = jnp.minimum(large, REL_BUCKETS - 1)
    return jnp.where(n < max_exact, n, large)


def moba_attention(q, k, v, rel_bias):
    B, H, S, dh = q.shape
    n_blk = max(-(-S // MOBA_BLOCK), MOBA_TOPK)
    pad = n_blk * MOBA_BLOCK - S
    kf = jnp.pad(k.astype(jnp.float32), ((0, 0), (0, 0), (0, pad), (0, 0)))
    vf = jnp.pad(v.astype(jnp.float32), ((0, 0), (0, 0), (0, pad), (0, 0)))
    kb = kf.reshape(B, H, n_blk, MOBA_BLOCK, dh)
    vb = vf.reshape(B, H, n_blk, MOBA_BLOCK, dh)
    k_mean = jnp.mean(kb, axis=3)
    tbl = rel_bias.astype(jnp.float32).T
    scale = dh ** -0.5
    n_q = S // MOBA_Q_BLOCK
    qs = q.astype(jnp.float32).reshape(B, H, n_q, MOBA_Q_BLOCK, dh).transpose(2, 0, 1, 3, 4)
    b_idx = jnp.arange(B)[:, None, None, None]
    h_idx = jnp.arange(H)[None, :, None, None]
    blk_ids = jnp.arange(n_blk)
    offs = jnp.arange(MOBA_BLOCK)
    rank_ids = jnp.arange(MOBA_TOPK)
    sel_w = MOBA_TOPK * MOBA_BLOCK

    def attend(args):
        qb, ci = args
        q0 = ci * MOBA_Q_BLOCK
        q_pos = q0 + jnp.arange(MOBA_Q_BLOCK)
        cur = q0 // MOBA_BLOCK
        gate = jnp.einsum('bhqd,bhnd->bhqn', qb, k_mean)
        gate = jnp.where(blk_ids < cur, gate, -jnp.inf)
        _, sel = lax.top_k(gate, MOBA_TOPK)
        valid = rank_ids < cur
        ks = kb[b_idx, h_idx, sel]
        vs = vb[b_idx, h_idx, sel]
        k_pos = sel[..., None] * MOBA_BLOCK + offs
        dist = q_pos[:, None, None] - k_pos
        s_sel = (jnp.einsum('bhqd,bhqnkd->bhqnk', qb, ks) * scale
                 + tbl[h_idx[..., None], t5_bucket(dist)])
        s_sel = jnp.where(valid[:, None], s_sel, -jnp.inf)
        k_own = lax.dynamic_index_in_dim(kb, cur, axis=2, keepdims=False)
        v_own = lax.dynamic_index_in_dim(vb, cur, axis=2, keepdims=False)
        dist_own = q_pos[:, None] - (cur * MOBA_BLOCK + offs)[None, :]
        s_own = jnp.einsum('bhqd,bhkd->bhqk', qb, k_own) * scale + tbl[:, t5_bucket(dist_own)]
        s_own = jnp.where(dist_own >= 0, s_own, -jnp.inf)
        logits = jnp.concatenate([s_sel.reshape(B, H, MOBA_Q_BLOCK, sel_w), s_own], axis=-1)
        probs = jax.nn.softmax(logits, axis=-1)
        p_sel = probs[..., :sel_w].reshape(B, H, MOBA_Q_BLOCK, MOBA_TOPK, MOBA_BLOCK)
        p_own = probs[..., sel_w:]
        return (jnp.einsum('bhqnk,bhqnkd->bhqd', p_sel, vs)
                + jnp.einsum('bhqk,bhkd->bhqd', p_own, v_own))

    out = lax.map(attend, (qs, jnp.arange(n_q)))
    return out.transpose(1, 2, 0, 3, 4).reshape(B, H, S, dh)


def chunked_gated_linear(q, k, v, log_a):
    B, H, S, dk = q.shape
    dv = v.shape[-1]
    n = S // CHUNK

    def to_chunks(t):
        return t.astype(jnp.float32).reshape(B, H, n, CHUNK, t.shape[-1]).transpose(2, 0, 1, 3, 4)

    qc, kc, vc, ac = to_chunks(q), to_chunks(k), to_chunks(v), to_chunks(log_a)
    bc = jnp.cumsum(ac, axis=-2)
    causal = jnp.tril(jnp.ones((CHUNK, CHUNK), dtype=bool))

    def step(state, inp):
        qb, kb, vb, bb = inp
        o_inter = jnp.einsum('bhtd,bhde->bhte', qb * jnp.exp(bb), state)
        diff = bb[:, :, :, None, :] - bb[:, :, None, :, :]
        decay = jnp.exp(jnp.where(causal[:, :, None], diff, -jnp.inf))
        scores = jnp.einsum('bhtd,bhsd,bhtsd->bhts', qb, kb, decay)
        o_intra = jnp.einsum('bhts,bhse->bhte', scores, vb)
        b_last = bb[:, :, -1:, :]
        new_state = (jnp.exp(b_last[:, :, 0, :])[..., None] * state
                     + jnp.einsum('bhsd,bhse->bhde', kb * jnp.exp(b_last - bb), vb))
        return new_state, o_inter + o_intra

    init = jnp.zeros((B, H, dk, dv), jnp.float32)
    _, out = lax.scan(step, init, (qc, kc, vc, bc))
    return out.transpose(1, 2, 0, 3, 4).reshape(B, H, S, dv)


def rotary(x):
    S, d = x.shape[2], x.shape[3]
    half = d // 2
    inv = ROPE_BASE ** (-jnp.arange(half, dtype=jnp.float32) / half)
    ang = jnp.arange(S, dtype=jnp.float32)[:, None] * inv[None, :]
    cos, sin = jnp.cos(ang), jnp.sin(ang)
    xf = x.astype(jnp.float32)
    x1, x2 = xf[..., :half], xf[..., half:]
    return jnp.concatenate([x1 * cos - x2 * sin, x1 * sin + x2 * cos], axis=-1)


def retention_chunkwise(q, k, v):
    B, H, S, dk = q.shape
    dv = v.shape[-1]
    n = S // CHUNK
    log_g = jnp.log1p(-jnp.exp2(-5.0 - jnp.arange(H, dtype=jnp.float32)))
    qc = q.astype(jnp.float32).reshape(B, H, n, CHUNK, dk)
    kc = k.astype(jnp.float32).reshape(B, H, n, CHUNK, dk)
    vc = v.astype(jnp.float32).reshape(B, H, n, CHUNK, dv)
    pos = jnp.arange(CHUNK, dtype=jnp.float32)
    rel = pos[:, None] - pos[None, :]
    dmask = jnp.where(rel >= 0, jnp.exp(jnp.maximum(rel, 0.0)[None] * log_g[:, None, None]), 0.0)
    scores = jnp.einsum('bhnid,bhnjd->bhnij', qc, kc) * dmask[:, None]
    o_intra = jnp.einsum('bhnij,bhnje->bhnie', scores, vc)
    zeta = jnp.exp((CHUNK - 1 - pos)[None, :] * log_g[:, None])
    u = jnp.einsum('bhnjd,bhnje->nbhde', kc * zeta[:, None, :, None], vc)
    g_chunk = jnp.exp(CHUNK * log_g)[:, None, None]

    def step(state, u_n):
        return g_chunk * state + u_n, state

    _, s_prev = lax.scan(step, jnp.zeros((B, H, dk, dv), jnp.float32), u)
    xi = jnp.exp((pos + 1.0)[None, :] * log_g[:, None])
    o_cross = jnp.einsum('bhnid,nbhde->bhnie', qc * xi[:, None, :, None], s_prev)
    return (o_intra + o_cross).reshape(B, H, S, dv)


def even_mixer(x, w_in, gla_w_gate, gla_b_gate, gla_norm, w_out, rel_bias):
    h = x @ w_in
    mq, mk, mv, gq, gk, gv, ga, gr = split_cols(h, EVEN_SPLITS)
    o_a = merge_heads(moba_attention(split_heads(mq, MOBA_HEADS), split_heads(mk, MOBA_HEADS),
                                     split_heads(mv, MOBA_HEADS), rel_bias))
    log_a = jax.nn.log_sigmoid((ga @ gla_w_gate + gla_b_gate).astype(jnp.float32)) / GLA_TAU
    o_b = chunked_gated_linear(split_heads(gq, GLA_HEADS).astype(jnp.float32) * GLA_DK ** -0.5,
                               split_heads(gk, GLA_HEADS), split_heads(gv, GLA_HEADS),
                               split_heads(log_a, GLA_HEADS))
    o_b = head_rms_norm(o_b, gla_norm) * jax.nn.silu(gr.astype(jnp.float32))
    return jnp.concatenate([o_a, o_b], axis=-1).astype(x.dtype) @ w_out


def odd_mixer(x, w_in, lb, hgrn_norm, ret_norm, w_out):
    h = x @ w_in
    hq, hf, hi, hg, rq, rk, rv, rg = split_cols(h, ODD_SPLITS)
    f = lb + (1.0 - lb) * jax.nn.sigmoid(hf.astype(jnp.float32))
    o_c = chunked_gated_linear(split_heads(hq, HGRN_HEADS), split_heads(1.0 - f, HGRN_HEADS),
                               split_heads(hi, HGRN_HEADS), split_heads(jnp.log(f), HGRN_HEADS))
    o_c = head_rms_norm(o_c, hgrn_norm) * jax.nn.silu(hg.astype(jnp.float32))
    q = rotary(split_heads(rq, RET_HEADS))
    k = rotary(split_heads(rk, RET_HEADS)) * RET_DK ** -0.5
    o_d = retention_chunkwise(q, k, split_heads(rv, RET_HEADS))
    o_d = head_layer_norm(o_d, ret_norm) * jax.nn.silu(rg.astype(jnp.float32))
    return jnp.concatenate([o_c, o_d], axis=-1).astype(x.dtype) @ w_out


def swiglu(x, w1, w3, w2):
    return (jax.nn.silu(x @ w1) * (x @ w3)) @ w2


def moe_swiglu(x, w_router, b_router, w1, w3, w2):
    B, S, D = x.shape
    n_tok = B * S
    n_asg = n_tok * TOP_K
    xf = x.reshape(n_tok, D)
    logits = (xf @ w_router).astype(jnp.float32) + b_router.astype(jnp.float32)
    top_logit, top_e = lax.top_k(logits, TOP_K)
    gates = jax.nn.softmax(top_logit, axis=-1)
    e_flat = top_e.reshape(-1).astype(jnp.int32)
    tok_flat = jnp.repeat(jnp.arange(n_tok, dtype=jnp.int32), TOP_K)
    g_flat = gates.reshape(-1)
    order = jnp.argsort(e_flat)
    e_s, tok_s, g_s = e_flat[order], tok_flat[order], g_flat[order]
    counts = jax.ops.segment_sum(jnp.ones_like(e_flat), e_flat, num_segments=N_EXPERTS)
    starts = jnp.cumsum(counts) - counts
    padded = (counts + MOE_BLOCK - 1) // MOE_BLOCK * MOE_BLOCK
    p_ends = jnp.cumsum(padded)
    p_starts = p_ends - padded
    dest = p_starts[e_s] + jnp.arange(n_asg, dtype=jnp.int32) - starts[e_s]
    n_rows = n_asg + N_EXPERTS * MOE_BLOCK
    tok_buf = jnp.zeros((n_rows,), jnp.int32).at[dest].set(tok_s)
    g_buf = jnp.zeros((n_rows,), jnp.float32).at[dest].set(g_s)
    n_blocks = n_rows // MOE_BLOCK
    blk_start = jnp.arange(n_blocks, dtype=jnp.int32) * MOE_BLOCK
    blk_e = jnp.minimum(jnp.searchsorted(p_ends, blk_start, side='right'), N_EXPERTS - 1)

    def expert_block(args):
        toks, e = args
        xb = xf[toks]
        return (jax.nn.silu(xb @ w1[e]) * (xb @ w3[e])) @ w2[e]

    y = lax.map(expert_block, (tok_buf.reshape(n_blocks, MOE_BLOCK), blk_e))
    y = y.reshape(n_rows, D).astype(jnp.float32) * g_buf[:, None]
    out = jnp.zeros((n_tok, D), jnp.float32).at[tok_buf].add(y)
    return out.reshape(B, S, D).astype(x.dtype)


def setup_inputs(seed: int = 0) -> dict:
    key = jax.random.key(seed)
    ks = iter(jax.random.split(key, 32))

    def nrm(shape, scale):
        return jax.random.normal(next(ks), shape, jnp.float32) * scale

    D = D_MODEL
    return {
        'x': nrm((BATCH, SEQ, D), 1.0),
        'p': nrm((DEPTH, BATCH, SEQ, PLE_DIM), 1.0),
        'rel_bias': nrm((REL_BUCKETS, MOBA_HEADS), 0.5),
        'even_w_in': nrm((N_EVEN, D, EVEN_IN), D ** -0.5),
        'gla_w_gate': nrm((N_EVEN, GLA_GATE_RANK, GLA_HEADS * GLA_DK), GLA_GATE_RANK ** -0.5),
        'gla_b_gate': nrm((N_EVEN, GLA_HEADS * GLA_DK), 0.1),
        'gla_norm': 1.0 + nrm((N_EVEN, GLA_HEADS * GLA_DV), 0.02),
        'even_w_out': nrm((N_EVEN, EVEN_OUT, D), EVEN_OUT ** -0.5 * DN_BETA),
        'odd_w_in': nrm((N_ODD, D, ODD_IN), D ** -0.5),
        'hgrn_gamma': nrm((DEPTH, HGRN_HEADS * HGRN_DK), 1.0),
        'hgrn_norm': 1.0 + nrm((N_ODD, HGRN_HEADS * HGRN_DV), 0.02),
        'ret_norm': 1.0 + nrm((N_ODD, RET_HEADS * RET_DV), 0.02),
        'odd_w_out': nrm((N_ODD, ODD_OUT, D), ODD_OUT ** -0.5 * DN_BETA),
        'ln_mix_g': 1.0 + nrm((DEPTH, D), 0.02),
        'ln_mix_b': nrm((DEPTH, D), 0.02),
        'ln_ffn_g': 1.0 + nrm((DEPTH, D), 0.02),
        'ln_ffn_b': nrm((DEPTH, D), 0.02),
        'ffn_w1': nrm((N_EVEN, D, FFN_DENSE), D ** -0.5),
        'ffn_w3': nrm((N_EVEN, D, FFN_DENSE), D ** -0.5),
        'ffn_w2': nrm((N_EVEN, FFN_DENSE, D), FFN_DENSE ** -0.5 * DN_BETA),
        'router_w': nrm((N_ODD, D, N_EXPERTS), D ** -0.5),
        'router_b': nrm((N_ODD, N_EXPERTS), 0.01),
        'expert_w1': nrm((N_ODD, N_EXPERTS, D, FFN_EXPERT), D ** -0.5),
        'expert_w3': nrm((N_ODD, N_EXPERTS, D, FFN_EXPERT), D ** -0.5),
        'expert_w2': nrm((N_ODD, N_EXPERTS, FFN_EXPERT, D), FFN_EXPERT ** -0.5 * DN_BETA),
        'ple_w_gate': nrm((DEPTH, D, D), D ** -0.5),
        'ple_w_proj': nrm((DEPTH, PLE_DIM, D), PLE_DIM ** -0.5),
    }


def reference(x, p, rel_bias, even_w_in, gla_w_gate, gla_b_gate, gla_norm, even_w_out,
              odd_w_in, hgrn_gamma, hgrn_norm, ret_norm, odd_w_out,
              ln_mix_g, ln_mix_b, ln_ffn_g, ln_ffn_b, ffn_w1, ffn_w3, ffn_w2,
              router_w, router_b, expert_w1, expert_w3, expert_w2, ple_w_gate, ple_w_proj):
    lb_p = jax.nn.softmax(hgrn_gamma.astype(jnp.float32), axis=0)
    lb_all = jnp.cumsum(lb_p, axis=0) - lb_p[0]
    for i in range(DEPTH):
        j = i // 2
        if i % 2 == 0:
            mix = even_mixer(x, even_w_in[j], gla_w_gate[j], gla_b_gate[j], gla_norm[j],
                             even_w_out[j], rel_bias)
        else:
            mix = odd_mixer(x, odd_w_in[j], lb_all[i], hgrn_norm[j], ret_norm[j], odd_w_out[j])
        x = layer_norm(DN_ALPHA * x + mix, ln_mix_g[i], ln_mix_b[i])
        if i % 2 == 0:
            ffn = swiglu(x, ffn_w1[j], ffn_w3[j], ffn_w2[j])
        else:
            ffn = moe_swiglu(x, router_w[j], router_b[j], expert_w1[j], expert_w3[j], expert_w2[j])
        x = layer_norm(DN_ALPHA * x + ffn, ln_ffn_g[i], ln_ffn_b[i])
        x = x + jax.nn.sigmoid(x @ ple_w_gate[i]) * (p[i] @ ple_w_proj[i])
    return x
```

```cpp
#include <hip/hip_runtime.h>
#include <cstdio>
#include <cstdint>

#define LAS __attribute__((address_space(3)))
#define GAS __attribute__((address_space(1)))
typedef _Float16 h16;
typedef _Float16 h16x8 __attribute__((ext_vector_type(8)));
typedef _Float16 h16x4 __attribute__((ext_vector_type(4)));
typedef _Float16 h16x2 __attribute__((ext_vector_type(2)));
typedef __bf16 b16x8 __attribute__((ext_vector_type(8)));
typedef float f32x4 __attribute__((ext_vector_type(4)));
typedef float f32x2 __attribute__((ext_vector_type(2)));
typedef unsigned u32x4 __attribute__((ext_vector_type(4)));
typedef unsigned u32x2 __attribute__((ext_vector_type(2)));
typedef GAS unsigned gu32;
#define RLX_AGENT __ATOMIC_RELAXED, __HIP_MEMORY_SCOPE_AGENT
#define LDS_WAIT() asm volatile("s_waitcnt lgkmcnt(0)" ::: "memory")
#define VM_WAIT() asm volatile("s_waitcnt vmcnt(0)" ::: "memory")

constexpr int BATCH = 2, SEQ = 16384, DM = 1024, M = BATCH * SEQ;
constexpr int NWAVES = 8, NTHR = 512;
constexpr float DN_ALPHA = 1.4142135623730951f;
constexpr float LN_EPS = 1e-5f, HEAD_EPS = 1e-6f;
constexpr int N0 = 3328;
constexpr int N1 = 3072;
constexpr int C0_MQ = 0, C0_MK = 512, C0_MV = 1024, C0_GQ = 1536, C0_GK = 1792, C0_GV = 2048, C0_GR = 2560, C0_GA = 3072;
constexpr int C1_HQ = 0, C1_HF = 256, C1_HI = 512, C1_HG = 1024, C1_RQ = 1536, C1_RK = 1792, C1_RV = 2048, C1_RG = 2560;
constexpr int FD = 2752, FDP = 2816;
constexpr int FE = 3584, NEXP = 8;
constexpr int PLE = 256;
constexpr int MOE_PANELS = 264;
constexpr int MOE_PASSES = 4, MOE_PPP = 66;

namespace pg8 {
constexpr int BM = 256, BK = 64, HALF = 128, HTB = HALF * BK * 2, STAGE_BYTES = 8 * HTB, NXCD = 8, WGM = 8;
__host__ __device__ __forceinline__ int lds_byte(int r, int c) { const int st = (r >> 4) * 2 + (c >> 5), rr = r & 15, cc = c & 31, ob = rr * 64 + cc * 2; return st * 1024 + (ob ^ (((ob >> 9) & 1) << 5)); }
__host__ __device__ __forceinline__ void stage_rc(int b, int& R, int& C) { const int st = b / 1024, sb = b % 1024, swz = sb ^ (((sb >> 9) & 1) << 5); R = (st >> 1) * 16 + swz / 64; C = (st & 1) * 32 + (swz % 64) / 2; }
__host__ __device__ __forceinline__ int perm32(int rho) { const int n = rho >> 4, i = rho & 15; return 8 * (i >> 2) + 4 * n + (i & 3); }

struct Unit { int pa, pb, pm, pn; };
struct Gemm { const h16* A; const h16* Bt; int K; };

struct StaticOrder {
    int nM, nN, nwg, G, c;
    __device__ void init(int Mrows, int N, int G_, int c_) { nM = Mrows / BM; nN = N / BM; nwg = nM * nN; G = G_; c = c_; }
    __device__ bool next(int i, Unit& u) const {
        const long L = (long)i * G + c; if (L >= nwg) return false;
        int wgid = (int)L; { const int q = nwg / NXCD, r = nwg % NXCD, xcd = wgid % NXCD, off = wgid / NXCD; wgid = (xcd < r ? xcd * (q + 1) : r * (q + 1) + (xcd - r) * q) + off; }
        const int nig = WGM * nN, gid = wgid / nig, fm = gid * WGM, gsz = (nM - fm) < WGM ? (nM - fm) : WGM;
        u.pm = fm + ((wgid % nig) % gsz); u.pn = (wgid % nig) / gsz; u.pa = u.pm; u.pb = u.pn; return true;
    }
};
struct MoeOrder {
    int P0, nM, nN, nwg, G, c, up; const int* pexp;
    __device__ void init(int P0_, int P1_, int nN_, int G_, int c_, int up_, const int* pexp_) { P0 = P0_; nM = P1_ - P0_; if (nM < 0) nM = 0; nN = nN_; nwg = nM * nN; G = G_; c = c_; up = up_; pexp = pexp_; }
    __device__ bool next(int i, Unit& u) const {
        const long L = (long)i * G + c; if (L >= nwg) return false;
        int wgid = (int)L; { const int q = nwg / NXCD, r = nwg % NXCD, xcd = wgid % NXCD, off = wgid / NXCD; wgid = (xcd < r ? xcd * (q + 1) : r * (q + 1) + (xcd - r) * q) + off; }
        const int nig = WGM * nN, gid = wgid / nig, fm = gid * WGM, gsz = (nM - fm) < WGM ? (nM - fm) : WGM;
        const int pl = fm + ((wgid % nig) % gsz), pn = (wgid % nig) / gsz;
        const int e = __builtin_amdgcn_readfirstlane(pexp[P0 + pl]);
        u.pn = pn; u.pb = e * nN + pn;
        if (up) { u.pa = P0 + pl; u.pm = pl; } else { u.pa = pl; u.pm = P0 + pl; }
        return true;
    }
};

__device__ __forceinline__ h16x8 pack8(const f32x4 a, const f32x4 b) { h16x8 w; w[0] = (h16)a[0]; w[1] = (h16)a[1]; w[2] = (h16)a[2]; w[3] = (h16)a[3]; w[4] = (h16)b[0]; w[5] = (h16)b[1]; w[6] = (h16)b[2]; w[7] = (h16)b[3]; return w; }
__device__ __forceinline__ float silu_f(float x) { return x * __builtin_amdgcn_rcpf(1.0f + __expf(-x)); }
__device__ __forceinline__ float sigmoid_f(float x) { return __builtin_amdgcn_rcpf(1.0f + __expf(-x)); }

struct EpiStoreH {
    h16* O; int ldc;
    __device__ __forceinline__ void operator()(const f32x4 (&acc)[2][2][4][2], const Unit& u, int wr, int wc, int fr, int fq) const {
        const int row0 = u.pm * BM + wr * 64 + fr, col0 = u.pn * BM + wc * 32 + 8 * fq;
#pragma unroll
        for (int ai = 0; ai < 2; ++ai)
#pragma unroll
            for (int m = 0; m < 4; ++m) { h16* rowp = O + (size_t)(row0 + ai * HALF + m * 16) * ldc + col0;
#pragma unroll
                for (int bj = 0; bj < 2; ++bj) *(h16x8*)(rowp + bj * HALF) = pack8(acc[ai][bj][m][0], acc[ai][bj][m][1]); }
    }
};
struct EpiResid {
    h16* Y; const h16* R;
    __device__ __forceinline__ void operator()(const f32x4 (&acc)[2][2][4][2], const Unit& u, int wr, int wc, int fr, int fq) const {
        const int row0 = u.pm * BM + wr * 64 + fr, col0 = u.pn * BM + wc * 32 + 8 * fq;
#pragma unroll
        for (int ai = 0; ai < 2; ++ai)
#pragma unroll
            for (int m = 0; m < 4; ++m) { const size_t off = (size_t)(row0 + ai * HALF + m * 16) * DM + col0;
#pragma unroll
                for (int bj = 0; bj < 2; ++bj) { const h16x8 r = *(const h16x8*)(R + off + bj * HALF); const f32x4 a = acc[ai][bj][m][0], b = acc[ai][bj][m][1]; h16x8 w;
#pragma unroll
                    for (int j = 0; j < 4; ++j) { w[j] = (h16)(DN_ALPHA * (float)r[j] + a[j]); w[4 + j] = (h16)(DN_ALPHA * (float)r[4 + j] + b[j]); }
                    *(h16x8*)(Y + off + bj * HALF) = w; } }
    }
};
struct EpiSwiGLU {
    h16* Hd; int ldh;
    __device__ __forceinline__ void operator()(const f32x4 (&acc)[2][2][4][2], const Unit& u, int wr, int wc, int fr, int fq) const {
        const int row0 = u.pm * BM + wr * 64 + fr, col0 = u.pn * HALF + wc * 32 + 8 * fq;
#pragma unroll
        for (int ai = 0; ai < 2; ++ai)
#pragma unroll
            for (int m = 0; m < 4; ++m) { h16x8 w;
#pragma unroll
                for (int n = 0; n < 2; ++n)
#pragma unroll
                    for (int j = 0; j < 4; ++j) w[4 * n + j] = (h16)(silu_f(acc[ai][0][m][n][j]) * acc[ai][1][m][n][j]);
                *(h16x8*)(Hd + (size_t)(row0 + ai * HALF + m * 16) * ldh + col0) = w; }
    }
};
struct EpiPle {
    const h16* X; const h16* PP; h16* Oh; float* Of; int fin;
    __device__ __forceinline__ void operator()(const f32x4 (&acc)[2][2][4][2], const Unit& u, int wr, int wc, int fr, int fq) const {
        const int row0 = u.pm * BM + wr * 64 + fr, col0 = u.pn * BM + wc * 32 + 8 * fq;
#pragma unroll
        for (int ai = 0; ai < 2; ++ai)
#pragma unroll
            for (int m = 0; m < 4; ++m) { const size_t off = (size_t)(row0 + ai * HALF + m * 16) * DM + col0;
#pragma unroll
                for (int bj = 0; bj < 2; ++bj) { const h16x8 x = *(const h16x8*)(X + off + bj * HALF), p = *(const h16x8*)(PP + off + bj * HALF); const f32x4 a = acc[ai][bj][m][0], b = acc[ai][bj][m][1];
                    f32x4 o0, o1;
#pragma unroll
                    for (int j = 0; j < 4; ++j) { o0[j] = (float)x[j] + sigmoid_f(a[j]) * (float)p[j]; o1[j] = (float)x[4 + j] + sigmoid_f(b[j]) * (float)p[4 + j]; }
                    if (fin) { *(f32x4*)(Of + off + bj * HALF) = o0; *(f32x4*)(Of + off + bj * HALF + 4) = o1; }
                    else *(h16x8*)(Oh + off + bj * HALF) = pack8(o0, o1); } }
    }
};
struct EpiMoeDown {
    h16* ys; const int* rowslot; const int* meta;
    __device__ __forceinline__ void operator()(const f32x4 (&acc)[2][2][4][2], const Unit& u, int wr, int wc, int fr, int fq) const {
        const int row0 = u.pm * BM + wr * 64 + fr, col0 = u.pn * BM + wc * 32 + 8 * fq;
        const int e = u.pb >> 2;
        const int lim = meta[8 + e] + meta[e];
#pragma unroll
        for (int ai = 0; ai < 2; ++ai)
#pragma unroll
            for (int m = 0; m < 4; ++m) { const int r = row0 + ai * HALF + m * 16;
                if (r < lim) { const int slot = rowslot[r]; h16* rowp = ys + (size_t)slot * DM + col0;
#pragma unroll
                    for (int bj = 0; bj < 2; ++bj) *(h16x8*)(rowp + bj * HALF) = pack8(acc[ai][bj][m][0], acc[ai][bj][m][1]); } }
    }
};

template <class Epi, class Sched, bool ALIGN_EPI>
__device__ __forceinline__ void gemm_phase(LAS unsigned char* lds, const Gemm g, const Sched& S, const Epi& E) {
    int tid_ = threadIdx.x; asm volatile("" : "+v"(tid_));
    const int tid = tid_, wid = __builtin_amdgcn_readfirstlane(tid >> 6), lane = tid & 63, wr = wid >> 2, wc = wid & 3, fr = lane & 15, fq = lane >> 4;
    const int K = g.K, nt = K / BK;
    unsigned voffA[2], voffB[2];
#pragma unroll
    for (int i = 0; i < 2; ++i) { int R, C; stage_rc(tid * 16 + i * 8192, R, C); const int Rb = (R & ~31) + perm32(R & 31);
        voffA[i] = (unsigned)(R * K + C) * 2u; voffB[i] = (unsigned)(Rb * K + C) * 2u; }
    const size_t kstep = (size_t)(BK * 2);
    const size_t hstep = (size_t)HALF * K * 2;
    const size_t tstep = 2 * hstep;
    const unsigned ldsw = (unsigned)wid * 1024u;
    const int aoff = lds_byte(wr * 64 + fr, fq * 8), boff = lds_byte(wc * 32 + fr, fq * 8);
#define PG8_SA(b, h) (((b) * 2 + (h)) * HTB)
#define PG8_SB(b, h) ((4 + (b) * 2 + (h)) * HTB)
#define PG8_STAGE(bufoff, gbase, voff) do { _Pragma("unroll") for (int _i = 0; _i < 2; ++_i) \
        __builtin_amdgcn_global_load_lds((const unsigned*)((const char*)(gbase) + (voff)[_i]), (LAS unsigned*)(lds + (bufoff) + ldsw + _i * 8192), 16, 0, 0); } while (0)
#define PG8_LDA(dst, b, h) do { _Pragma("unroll") for (int m = 0; m < 4; ++m) _Pragma("unroll") for (int k = 0; k < 2; ++k) dst[m][k] = *(const LAS h16x8*)(lds + PG8_SA(b, h) + aoff + m * 2048 + k * 1024); } while (0)
#define PG8_LDB(dst, b, h) do { _Pragma("unroll") for (int n = 0; n < 2; ++n) _Pragma("unroll") for (int k = 0; k < 2; ++k) dst[n][k] = *(const LAS h16x8*)(lds + PG8_SB(b, h) + boff + n * 2048 + k * 1024); } while (0)
#define PG8_MMA(ai, bj, At, Bt) do { __builtin_amdgcn_s_setprio(1); _Pragma("unroll") for (int m = 0; m < 4; ++m) _Pragma("unroll") for (int n = 0; n < 2; ++n) _Pragma("unroll") for (int k = 0; k < 2; ++k) \
        acc[ai][bj][m][n] = __builtin_amdgcn_mfma_f32_16x16x32_f16(Bt[n][k], At[m][k], acc[ai][bj][m][n], 0, 0, 0); __builtin_amdgcn_s_setprio(0); } while (0)
#define PG8_WAIT_V(n) asm volatile("s_waitcnt vmcnt(" #n ")" ::: "memory")
#define PG8_WAIT_L(n) asm volatile("s_waitcnt lgkmcnt(" #n ")" ::: "memory")
#define PG8_BAR __builtin_amdgcn_s_barrier()
#define PG8_SCHED __builtin_amdgcn_sched_barrier(0)
    Unit cur, nxt; int ui = 0;
    if (!S.next(0, cur)) return;
    f32x4 acc[2][2][4][2];
#pragma unroll
    for (int a = 0; a < 2; ++a)
#pragma unroll
        for (int b = 0; b < 2; ++b)
#pragma unroll
            for (int m = 0; m < 4; ++m)
#pragma unroll
                for (int n = 0; n < 2; ++n) acc[a][b][m][n] = (f32x4){0.f, 0.f, 0.f, 0.f};
    h16x8 At[4][2], B0[2][2], B1[2][2];
    const char* cA = (const char*)g.A + (size_t)cur.pa * tstep; const char* cB = (const char*)g.Bt + (size_t)cur.pb * tstep;
    PG8_STAGE(PG8_SB(0, 0), cB, voffB); PG8_STAGE(PG8_SB(0, 1), cB + hstep, voffB); PG8_STAGE(PG8_SA(0, 0), cA, voffA); PG8_STAGE(PG8_SA(0, 1), cA + hstep, voffA);
    if (wr == 1) PG8_BAR;
    PG8_WAIT_V(2); PG8_BAR;
    PG8_STAGE(PG8_SB(1, 0), cB + kstep, voffB); PG8_STAGE(PG8_SA(1, 0), cA + kstep, voffA); PG8_STAGE(PG8_SB(1, 1), cB + hstep + kstep, voffB);
    PG8_WAIT_V(6); PG8_BAR;
    for (;;) {
        const bool has_next = S.next(ui + 1, nxt);
        const char* nA = has_next ? (const char*)g.A + (size_t)nxt.pa * tstep : cA; const char* nB = has_next ? (const char*)g.Bt + (size_t)nxt.pb * tstep : cB;
        for (int t = 0; t < nt; t += 2) {
            const bool last = (t == nt - 2);
            const char* a1 = cA + (size_t)(t + 1) * kstep;
            const char* a2 = last ? nA : cA + (size_t)(t + 2) * kstep; const char* b2 = last ? nB : cB + (size_t)(t + 2) * kstep;
            const char* a3 = a2 + kstep; const char* b3 = b2 + kstep;
            PG8_LDB(B0, 0, 0); PG8_LDB(B1, 0, 1); PG8_SCHED; PG8_LDA(At, 0, 0); PG8_STAGE(PG8_SA(1, 1), a1 + hstep, voffA);
            PG8_WAIT_V(8); PG8_WAIT_L(0); PG8_BAR; PG8_MMA(0, 0, At, B0); PG8_MMA(0, 1, At, B1); PG8_BAR; PG8_SCHED;
            PG8_LDA(At, 0, 1); PG8_STAGE(PG8_SB(0, 0), b2, voffB); PG8_STAGE(PG8_SB(0, 1), b2 + hstep, voffB); PG8_STAGE(PG8_SA(0, 0), a2, voffA);
            PG8_WAIT_V(8); PG8_WAIT_L(0); PG8_BAR; PG8_MMA(1, 0, At, B0); PG8_MMA(1, 1, At, B1); PG8_BAR; PG8_SCHED;
            PG8_LDB(B0, 1, 0); PG8_LDB(B1, 1, 1); PG8_SCHED; PG8_LDA(At, 1, 0); PG8_STAGE(PG8_SA(0, 1), a2 + hstep, voffA);
            PG8_WAIT_V(8); PG8_WAIT_L(0); PG8_BAR; PG8_MMA(0, 0, At, B0); PG8_MMA(0, 1, At, B1); PG8_BAR; PG8_SCHED;
            PG8_LDA(At, 1, 1); PG8_STAGE(PG8_SB(1, 0), b3, voffB); PG8_STAGE(PG8_SB(1, 1), b3 + hstep, voffB); PG8_STAGE(PG8_SA(1, 0), a3, voffA);
            PG8_WAIT_V(8); PG8_WAIT_L(0); PG8_BAR; PG8_MMA(1, 0, At, B0); PG8_MMA(1, 1, At, B1); PG8_BAR; PG8_SCHED;
        }
        if constexpr (ALIGN_EPI) { if (wr == 0) PG8_BAR; }
        E(acc, cur, wr, wc, fr, fq);
        if (!has_next) break;
#pragma unroll
        for (int a = 0; a < 2; ++a)
#pragma unroll
            for (int b = 0; b < 2; ++b)
#pragma unroll
                for (int m = 0; m < 4; ++m)
#pragma unroll
                    for (int n = 0; n < 2; ++n) acc[a][b][m][n] = (f32x4){0.f, 0.f, 0.f, 0.f};
        cur = nxt; cA = nA; cB = nB; ++ui;
        if constexpr (ALIGN_EPI) { if (wr == 1) PG8_BAR; }
    }
    PG8_WAIT_V(0);
    if constexpr (!ALIGN_EPI) { if (wr == 0) PG8_BAR; }
    PG8_BAR;
#undef PG8_SA
#undef PG8_SB
#undef PG8_STAGE
#undef PG8_LDA
#undef PG8_LDB
#undef PG8_MMA
#undef PG8_WAIT_V
#undef PG8_WAIT_L
#undef PG8_BAR
#undef PG8_SCHED
}
}

constexpr size_t MiB = 1u << 20;
constexpr size_t WS_CTL = 0, CTL_ZERO_BYTES = 1 * MiB;
constexpr size_t WS_KMEAN = 1 * MiB;
constexpr size_t WS_BIASL = 1 * MiB + 512 * 1024;
constexpr size_t WS_META = 1 * MiB + 768 * 1024;
constexpr size_t WS_ROUTE = 2 * MiB;
constexpr size_t WS_ROWSLOT = 3 * MiB;
constexpr size_t WS_ROPE = 4 * MiB;
constexpr size_t WS_WIN0 = 8 * MiB;
constexpr size_t WS_WOUT0 = 15 * MiB;
constexpr size_t WS_W13_0 = 17 * MiB;
constexpr size_t WS_W2_0 = 28 * MiB;
constexpr size_t WS_WG0 = 34 * MiB, WS_WG1 = 36 * MiB;
constexpr size_t WS_WP0 = 38 * MiB, WS_WP1 = 38 * MiB + 512 * 1024;
constexpr size_t WS_WIN1 = 39 * MiB;
constexpr size_t WS_WOUT1 = 45 * MiB;
constexpr size_t WS_PH = 48 * MiB;
constexpr size_t WS_XA = 80 * MiB, WS_XB = 144 * MiB;
constexpr size_t WS_R = 208 * MiB;
constexpr size_t WS_H = WS_R;
constexpr size_t WS_Y = WS_R;
constexpr size_t WS_MIXIN0 = WS_R + 208 * MiB;
constexpr size_t WS_U0 = WS_R + 272 * MiB, WS_ST0 = WS_R + 304 * MiB, WS_DV0 = WS_R + 336 * MiB;
constexpr size_t WS_LIST = WS_R + 340 * MiB;
constexpr size_t WS_HID = WS_R + 64 * MiB;
constexpr size_t WS_PP = WS_R + 244 * MiB;
constexpr size_t WS_MIXIN1 = WS_R + 192 * MiB;
constexpr size_t WS_U1 = WS_R + 256 * MiB, WS_ST1 = WS_R + 320 * MiB, WS_DV1 = WS_R + 384 * MiB;
constexpr size_t WS_E2 = WS_XB;
constexpr size_t WS_E13 = WS_R;
constexpr size_t WS_XS = WS_R + 112 * MiB;
constexpr size_t WS_HQ = WS_R + 244 * MiB;
constexpr size_t WS_END = 600 * MiB;
static_assert(WS_DV1 + 1 * MiB <= WS_END && WS_HQ + (size_t)MOE_PPP * 256 * FE * 2 <= WS_END && WS_LIST + 16 * MiB <= WS_END, "ws map");
static_assert(WS_HID + (size_t)M * FDP * 2 <= WS_PP && WS_XS + (size_t)MOE_PANELS * 256 * DM * 2 <= WS_HQ, "ws map 2");
constexpr size_t DO_PO = 0, DO_PML = 96 * MiB;

constexpr int CW_BAR = 4096;
constexpr int CW_MOBACNT = 16384;
constexpr int CW_MOECNT = 20480;

constexpr int RING_BYTES = 131072;
constexpr int LDSCTL_OFF = RING_BYTES;
constexpr int LDS_X_OFF = RING_BYTES + 256;
constexpr int LDS_BYTES = 163840;

#define XB_TMO      128
#define XB_XCNT(j)  (256  + 64 * (j))
#define XB_XSUB(j)  (1280 + 64 * (j))
#define XB_XGEN(j)  (2304 + 64 * (j))
#define XB_TOP      3328
#define XB_TOPGEN   3392
#define XCD_BAR_WORDS 3456
#define XB_SPIN_CAP (1u << 18)
__device__ __forceinline__ unsigned xb_ld(unsigned* p)              { return __hip_atomic_load(p, __ATOMIC_RELAXED, __HIP_MEMORY_SCOPE_AGENT); }
__device__ __forceinline__ unsigned xb_add(unsigned* p, unsigned v) { return __hip_atomic_fetch_add(p, v, __ATOMIC_RELAXED, __HIP_MEMORY_SCOPE_AGENT); }
__device__ __forceinline__ unsigned xb_xcc_id() { return (unsigned)__builtin_amdgcn_s_getreg((3 << 11) | 20) & 0xFu; }
#define XB_SPIN(cond, bar) do { unsigned _sp = 0; while (cond) { __builtin_amdgcn_s_sleep(1); \
    if ((++_sp & 255u) == 0u) { if (xb_ld(&(bar)[XB_TMO])) break; if (_sp > XB_SPIN_CAP) { atomicAdd(&(bar)[XB_TMO], 1u); break; } } } } while (0)
struct XcdBarrier { unsigned* bar; unsigned x; volatile LAS unsigned* st; };
__device__ __forceinline__ XcdBarrier xcd_barrier_post(unsigned* bar, volatile LAS unsigned* st) {
    XcdBarrier b; b.bar = bar; b.x = xb_xcc_id(); b.st = st;
    if (threadIdx.x == 0) (void)xb_add(&bar[XB_XCNT(b.x)], 1u);
    return b;
}
__device__ __forceinline__ void xcd_barrier_complete(unsigned* bar, unsigned x, unsigned& nloc, unsigned& nx) {
    const unsigned G = gridDim.x * gridDim.y * gridDim.z;
    unsigned sum, cnt, mine, sp = 0u;
    for (;;) {
        sum = 0u; cnt = 0u; mine = 0u;
#pragma unroll
        for (unsigned j = 0; j < 16; ++j) { const unsigned c = xb_ld(&bar[XB_XCNT(j)]); sum += c; cnt += (c > 0u) ? 1u : 0u; mine = (j == x) ? c : mine; }
        if (sum == G) break;
        __builtin_amdgcn_s_sleep(1);
        if ((++sp & 255u) == 0u) { if (xb_ld(&bar[XB_TMO])) break; if (sp > XB_SPIN_CAP) { atomicAdd(&bar[XB_TMO], 1u); break; } }
    }
    nloc = mine > 0u ? mine : 1u; nx = cnt > 0u ? cnt : 1u;
}
__device__ __forceinline__ void xcd_barrier(const XcdBarrier& b) {
    asm volatile("s_waitcnt vmcnt(0)" ::: "memory");
    __syncthreads();
    if (threadIdx.x == 0) {
        unsigned* bar = b.bar;
        __builtin_amdgcn_s_waitcnt(0);
        unsigned nloc = b.st[0], nx = b.st[1];
        if (nloc == 0u) { xcd_barrier_complete(bar, b.x, nloc, nx); b.st[0] = nloc; b.st[1] = nx; }
        const unsigned old = xb_add(&bar[XB_XSUB(b.x)], 1u);
        const unsigned gen = old / nloc;
        if (old + 1u == (gen + 1u) * nloc) {
            __builtin_amdgcn_fence(__ATOMIC_RELEASE, "agent");
            asm volatile("s_waitcnt vmcnt(0)" ::: "memory");
            const unsigned og = xb_add(&bar[XB_TOP], 1u);
            const unsigned tg = og / nx;
            if (og + 1u == (tg + 1u) * nx) xb_add(&bar[XB_TOPGEN], 1u);
            else XB_SPIN(xb_ld(&bar[XB_TOPGEN]) == tg, bar);
            __builtin_amdgcn_fence(__ATOMIC_ACQUIRE, "agent");
            xb_add(&bar[XB_XGEN(b.x)], 1u);
            asm volatile("s_waitcnt vmcnt(0)" ::: "memory");
        } else {
            XB_SPIN(xb_ld(&bar[XB_XGEN(b.x)]) == gen, bar);
            __builtin_amdgcn_fence(__ATOMIC_ACQUIRE, "agent");
            asm volatile("s_waitcnt vmcnt(0)" ::: "memory");
        }
    }
    __syncthreads();
}

struct Args { const float* in[27]; float* out; unsigned char* ws; int ph_lo, ph_hi; };
enum InIdx { I_X = 0, I_P, I_RELB, I_EWIN, I_GLAWG, I_GLABG, I_GLAN, I_EWOUT, I_OWIN, I_HGAMMA, I_HNORM, I_RNORM, I_OWOUT, I_LMG, I_LMB, I_LFG, I_LFB,
             I_FW1, I_FW3, I_FW2, I_RW, I_RB, I_XW1, I_XW3, I_XW2, I_PWG, I_PWP };
struct Frame {
    LAS unsigned char* lds; int tid, lane, wave, vcu, G; unsigned char* ws; gu32* ctl; const Args* a;
};
__device__ __forceinline__ void launder(Frame& F) {
    int t = threadIdx.x; asm volatile("" : "+v"(t)); F.tid = t; F.lane = t & 63; F.wave = __builtin_amdgcn_readfirstlane(t >> 6);
    unsigned char* w = F.ws; asm volatile("" : "+s"(w)); F.ws = w; F.ctl = (gu32*)(w + WS_CTL);
}
__device__ __forceinline__ float wave_sum(float v) {
#pragma unroll
    for (int o = 1; o < 64; o <<= 1) v += __shfl_xor(v, o);
    return v;
}

__device__ __forceinline__ int rowmap(int mode, int n) {
    if (mode == 0) return n;
    if (mode == 1) return n < 2560 ? n : (n < 2576 ? 3072 + (n - 2560) : 2560 + (n - 2576));
    if (mode == 2) return (n >> 7) * 256 + (n & 127);
    return (n >> 7) * 256 + 128 + (n & 127);
}
__device__ __forceinline__ void transpose_item(const float* W, int N, h16* WT, int ldk, int mode, LAS float* scr, int item, int lane) {
    const int nblk = (N + 31) / 32, kb = item / nblk, nb = item % nblk, k0 = 64 * kb, n0 = 32 * nb;
    const int nn = n0 + (lane & 31); const bool ok = nn < N;
#pragma unroll 8
    for (int i = 0; i < 32; ++i) { const int kk = 2 * i + (lane >> 5); scr[kk * 33 + (lane & 31)] = ok ? W[(size_t)(k0 + kk) * N + nn] : 0.f; }
    LDS_WAIT(); asm volatile("" ::: "memory");
    const int c = lane & 7;
#pragma unroll
    for (int j = 0; j < 4; ++j) { const int n = (lane >> 3) + 8 * j; const LAS float* s = scr + (8 * c) * 33 + n;
        if (n0 + n < N) { h16x8 o;
#pragma unroll
            for (int q = 0; q < 8; ++q) o[q] = (h16)s[q * 33];
            *(h16x8*)(WT + (size_t)rowmap(mode, n0 + n) * ldk + k0 + 8 * c) = o; } }
    LDS_WAIT(); asm volatile("" ::: "memory");
}
struct TDesc { const float* W; int K, N; h16* WT; int ldk, mode; };
__device__ __forceinline__ int titems(const TDesc& d) { return (d.K / 64) * ((d.N + 31) / 32); }

__device__ __forceinline__ void zero16(void* p) { *(u32x4*)p = (u32x4){0u, 0u, 0u, 0u}; }
__device__ __forceinline__ void cvt8(const float* src, h16* dst) { const f32x4 a = *(const f32x4*)src, b = *(const f32x4*)(src + 4); *(h16x8*)dst = pg8::pack8(a, b); }
__device__ __forceinline__ int t5_bucket(int n) {
    if (n < 16) return n < 0 ? 0 : n;
    int b = 16;
    b += (n >= 19) + (n >= 21) + (n >= 24) + (n >= 27) + (n >= 31) + (n >= 35) + (n >= 40) + (n >= 46) + (n >= 52) + (n >= 59) + (n >= 67) + (n >= 77) + (n >= 87) + (n >= 99) + (n >= 113);
    return b;
}
__device__ __forceinline__ void p_prologue(Frame& F) {
    const Args& A = *F.a; unsigned char* ws = F.ws;
    LAS float* scr = (LAS float*)(F.lds + F.wave * 16384);
    const int gw = F.vcu * NWAVES + F.wave, NGW = F.G * NWAVES;
    constexpr int T0 = 16 * 97, T1 = 16 * 32, T2 = 16 * 86, T3 = T2, T4 = 43 * 32, T5 = 16 * 32, T6 = T5, T7 = 4 * 32, T8 = T7, T9 = 16 * 96, T10 = 16 * 32;
    constexpr int NT = T0 + T1 + T2 + T3 + T4 + T5 + T6 + T7 + T8 + T9 + T10;
    for (int it = gw; it < NT; it += NGW) {
        int r = it;
        if (r < T0) { transpose_item(A.in[I_EWIN], 3088, (h16*)(ws + WS_WIN0), 1024, 1, scr, r, F.lane); continue; } r -= T0;
        if (r < T1) { transpose_item(A.in[I_EWOUT], 1024, (h16*)(ws + WS_WOUT0), 1024, 0, scr, r, F.lane); continue; } r -= T1;
        if (r < T2) { transpose_item(A.in[I_FW1], FD, (h16*)(ws + WS_W13_0), 1024, 2, scr, r, F.lane); continue; } r -= T2;
        if (r < T3) { transpose_item(A.in[I_FW3], FD, (h16*)(ws + WS_W13_0), 1024, 3, scr, r, F.lane); continue; } r -= T3;
        if (r < T4) { transpose_item(A.in[I_FW2], 1024, (h16*)(ws + WS_W2_0), FDP, 0, scr, r, F.lane); continue; } r -= T4;
        if (r < T5) { transpose_item(A.in[I_PWG], 1024, (h16*)(ws + WS_WG0), 1024, 0, scr, r, F.lane); continue; } r -= T5;
        if (r < T6) { transpose_item(A.in[I_PWG] + 1024 * 1024, 1024, (h16*)(ws + WS_WG1), 1024, 0, scr, r, F.lane); continue; } r -= T6;
        if (r < T7) { transpose_item(A.in[I_PWP], 1024, (h16*)(ws + WS_WP0), 256, 0, scr, r, F.lane); continue; } r -= T7;
        if (r < T8) { transpose_item(A.in[I_PWP] + 256 * 1024, 1024, (h16*)(ws + WS_WP1), 256, 0, scr, r, F.lane); continue; } r -= T8;
        if (r < T9) { transpose_item(A.in[I_OWIN], N1, (h16*)(ws + WS_WIN1), 1024, 0, scr, r, F.lane); continue; } r -= T9;
        transpose_item(A.in[I_OWOUT], 1024, (h16*)(ws + WS_WOUT1), 1024, 0, scr, r, F.lane);
    }
    const size_t gt = (size_t)F.vcu * NTHR + F.tid, NGT = (size_t)F.G * NTHR;
    { h16* w = (h16*)(ws + WS_WIN0) + (size_t)3088 * 1024; for (size_t i = gt; i < 30720; i += NGT) zero16(w + i * 8); }
    { h16* w = (h16*)(ws + WS_W13_0); for (size_t i = gt; i < 128 * 128; i += NGT) { const int rr = (int)(i >> 7), ch = (int)(i & 127); const int row = 21 * 256 + (rr < 64 ? 64 + rr : 128 + 64 + (rr - 64)); zero16(w + (size_t)row * 1024 + ch * 8); } }
    { h16* w = (h16*)(ws + WS_W2_0); for (size_t i = gt; i < 1024 * 8; i += NGT) { const int row = (int)(i >> 3), ch = (int)(i & 7); zero16(w + (size_t)row * FDP + FD + ch * 8); } }
    { const float* x = A.in[I_X]; h16* xa = (h16*)(ws + WS_XA); for (size_t i = gt; i < (size_t)M * DM / 8; i += NGT) cvt8(x + i * 8, xa + i * 8); }
    { const float* p = A.in[I_P]; h16* ph = (h16*)(ws + WS_PH); for (size_t i = gt; i < (size_t)2 * M * PLE / 8; i += NGT) cvt8(p + i * 8, ph + i * 8); }
    { float* rc = (float*)(ws + WS_ROPE); float* rs = rc + SEQ * 32;
      for (size_t i = gt; i < (size_t)SEQ * 32; i += NGT) { const int t = (int)(i >> 5), k = (int)(i & 31); const float inv = (float)pow(10000.0, -(double)k / 32.0); const float ang = (float)t * inv;
          rc[i] = (float)cos((double)ang); rs[i] = (float)sin((double)ang); } }
    { float* bl = (float*)(ws + WS_BIASL); const float* rb = A.in[I_RELB]; for (size_t i = gt; i < 8 * 128; i += NGT) { const int h = (int)(i >> 7), d = (int)(i & 127); bl[i] = rb[t5_bucket(d) * 8 + h]; } }
}

template <int MODE>
__device__ __forceinline__ void ln_phase(Frame& F, const h16* Y, const float* gam, const float* bet, h16* Xout, const h16* XR, const h16* ys) {
    const Args& A = *F.a;
    LAS float* wr_l = (LAS float*)F.lds;
    LAS int* rt_l = (LAS int*)(F.lds + 32768);
    LAS float* rg_l = (LAS float*)(F.lds + 32768 + 2048);
    LAS int* lcnt = (LAS int*)(F.lds + 32768 + 4096);
    int* route = (int*)(F.ws + WS_ROUTE);
    if (MODE == 1) { const float* rw = A.in[I_RW]; for (int i = F.tid; i < 8192; i += NTHR) wr_l[i] = rw[i]; }
    f32x4 g4[4], b4[4];
#pragma unroll
    for (int j = 0; j < 2; ++j) { const int c = j * 512 + F.lane * 8; g4[2 * j] = *(const f32x4*)(gam + c); g4[2 * j + 1] = *(const f32x4*)(gam + c + 4); b4[2 * j] = *(const f32x4*)(bet + c); b4[2 * j + 1] = *(const f32x4*)(bet + c + 4); }
    for (int rb = F.vcu * 128; rb < M; rb += F.G * 128) {
        if (MODE == 1) { if (F.tid < 16) lcnt[F.tid] = 0; __syncthreads(); }
        for (int i = 0; i < 16; ++i) {
            const int row = rb + F.wave * 16 + i;
            float v[16];
            if (MODE == 2) {
                const int* rr = route + (size_t)row * 8; const float g0 = __int_as_float(rr[4]), g1 = __int_as_float(rr[5]);
#pragma unroll
                for (int j = 0; j < 2; ++j) { const int c = j * 512 + F.lane * 8; const h16x8 xr = *(const h16x8*)(XR + (size_t)row * DM + c), y0 = *(const h16x8*)(ys + (size_t)(2 * row) * DM + c), y1 = *(const h16x8*)(ys + (size_t)(2 * row + 1) * DM + c);
#pragma unroll
                    for (int q = 0; q < 8; ++q) v[8 * j + q] = DN_ALPHA * (float)xr[q] + g0 * (float)y0[q] + g1 * (float)y1[q]; }
            } else {
#pragma unroll
                for (int j = 0; j < 2; ++j) { const h16x8 y = *(const h16x8*)(Y + (size_t)row * DM + j * 512 + F.lane * 8);
#pragma unroll
                    for (int q = 0; q < 8; ++q) v[8 * j + q] = (float)y[q]; }
            }
            float s = 0.f;
#pragma unroll
            for (int q = 0; q < 16; ++q) s += v[q];
            const float mean = wave_sum(s) * (1.f / DM); float s2 = 0.f;
#pragma unroll
            for (int q = 0; q < 16; ++q) { v[q] -= mean; s2 += v[q] * v[q]; }
            const float rstd = 1.f / sqrtf(wave_sum(s2) * (1.f / DM) + LN_EPS);
#pragma unroll
            for (int q = 0; q < 16; ++q) v[q] = v[q] * rstd * g4[q >> 2][q & 3] + b4[q >> 2][q & 3];
#pragma unroll
            for (int j = 0; j < 2; ++j) { h16x8 o;
#pragma unroll
                for (int q = 0; q < 8; ++q) o[q] = (h16)v[8 * j + q];
                *(h16x8*)(Xout + (size_t)row * DM + j * 512 + F.lane * 8) = o; }
            if (MODE == 1) {
                float lg[8];
#pragma unroll
                for (int e = 0; e < 8; ++e) lg[e] = 0.f;
#pragma unroll
                for (int j = 0; j < 2; ++j)
#pragma unroll
                    for (int q = 0; q < 8; ++q) { const int c = j * 512 + F.lane * 8 + q; const f32x4 w0 = *(const LAS f32x4*)(wr_l + c * 8), w1 = *(const LAS f32x4*)(wr_l + c * 8 + 4); const float x = v[8 * j + q];
                        lg[0] += x * w0[0]; lg[1] += x * w0[1]; lg[2] += x * w0[2]; lg[3] += x * w0[3]; lg[4] += x * w1[0]; lg[5] += x * w1[1]; lg[6] += x * w1[2]; lg[7] += x * w1[3]; }
#pragma unroll
                for (int e = 0; e < 8; ++e) lg[e] = wave_sum(lg[e]) + A.in[I_RB][e];
                if (F.lane == 0) {
                    int e0 = 0; float m0 = lg[0];
#pragma unroll
                    for (int e = 1; e < 8; ++e) if (lg[e] > m0) { m0 = lg[e]; e0 = e; }
                    int e1 = -1; float m1 = -INFINITY;
#pragma unroll
                    for (int e = 0; e < 8; ++e) if (e != e0 && lg[e] > m1) { m1 = lg[e]; e1 = e; }
                    const float g0 = 1.f / (1.f + expf(m1 - m0));
                    const int s0 = atomicAdd((int*)&lcnt[e0], 1), s1 = atomicAdd((int*)&lcnt[e1], 1);
                    const int li = F.wave * 16 + i;
                    rt_l[li * 4 + 0] = e0; rt_l[li * 4 + 1] = s0; rt_l[li * 4 + 2] = e1; rt_l[li * 4 + 3] = s1; rg_l[li * 2] = g0; rg_l[li * 2 + 1] = 1.f - g0;
                }
            }
        }
        if (MODE == 1) {
            __syncthreads();
            if (F.tid < 8) lcnt[8 + F.tid] = (int)__hip_atomic_fetch_add(F.ctl + CW_MOECNT + F.tid, (unsigned)lcnt[F.tid], RLX_AGENT);
            __syncthreads();
            if (F.tid < 128) { const int row = rb + F.tid; int* rr = route + (size_t)row * 8; const int e0 = rt_l[F.tid * 4], e1 = rt_l[F.tid * 4 + 2];
                rr[0] = e0; rr[1] = lcnt[8 + e0] + rt_l[F.tid * 4 + 1]; rr[2] = e1; rr[3] = lcnt[8 + e1] + rt_l[F.tid * 4 + 3]; rr[4] = __float_as_int(rg_l[F.tid * 2]); rr[5] = __float_as_int(rg_l[F.tid * 2 + 1]); }
            __syncthreads();
        }
    }
}

constexpr int KL_STRIDE = 72, VT_STRIDE = 264;
constexpr int LIST_PER_BH = 516096;
__device__ __forceinline__ int moba_binoff(int j) { return 256 * (63 * j - (j * (j - 1)) / 2); }

__device__ __forceinline__ void moba_kmean_unit(Frame& F, int u) {
    const int b = u >> 6, blk = u & 63; const h16* Hh = (const h16*)(F.ws + WS_H);
    const h16* p = Hh + (size_t)(b * SEQ + blk * 256) * N0 + C0_MK + F.tid;
    float s = 0.f;
#pragma unroll 8
    for (int r = 0; r < 256; ++r) s += (float)p[(size_t)r * N0];
    float* km = (float*)(F.ws + WS_KMEAN);
    km[((size_t)(b * 8 + (F.tid >> 6)) * 64 + blk) * 64 + (F.tid & 63)] = s * (1.f / 256.f);
}

__device__ __forceinline__ bool better(float av, int ai, float bv, int bi) { return av > bv || (av == bv && ai < bi); }
__device__ __forceinline__ void top3_insert(float g, int n, float& v0, int& i0, float& v1, int& i1, float& v2, int& i2) {
    const bool b2 = better(g, n, v2, i2), b1 = better(g, n, v1, i1), b0 = better(g, n, v0, i0);
    const float nv2 = b1 ? v1 : (b2 ? g : v2); const int ni2 = b1 ? i1 : (b2 ? n : i2);
    const float nv1 = b0 ? v0 : (b1 ? g : v1); const int ni1 = b0 ? i0 : (b1 ? n : i1);
    const float nv0 = b0 ? g : v0; const int ni0 = b0 ? n : i0;
    v0 = nv0; i0 = ni0; v1 = nv1; i1 = ni1; v2 = nv2; i2 = ni2;
}
__device__ __forceinline__ void moba_select_unit(Frame& F, int u) {
    const int bh = u / 63, c = 1 + u % 63, b = bh >> 3, h = bh & 7;
    LAS float* km = (LAS float*)F.lds; LAS int* hist = (LAS int*)(F.lds + 16384); LAS int* gbase = hist + 64;
    const float* kmg = (const float*)(F.ws + WS_KMEAN) + (size_t)bh * 64 * 64;
    __syncthreads();
    for (int i = F.tid; i < c * 64; i += NTHR) km[i] = kmg[i];
    if (F.tid < 64) hist[F.tid] = 0;
    const int q = F.tid >> 1, half = F.tid & 1;
    const h16* Hh = (const h16*)(F.ws + WS_H);
    const h16* qp = Hh + (size_t)(b * SEQ + c * 256 + q) * N0 + C0_MQ + h * 64;
    float qv[64];
#pragma unroll
    for (int j = 0; j < 8; ++j) { const h16x8 t = *(const h16x8*)(qp + 8 * j);
#pragma unroll
        for (int k = 0; k < 8; ++k) qv[8 * j + k] = (float)t[k]; }
    __syncthreads();
    float v0 = -INFINITY, v1 = -INFINITY, v2 = -INFINITY; int i0 = 1000, i1 = 1001, i2 = 1002;
    for (int n = half; n < c; n += 2) {
        const LAS f32x4* kr = (const LAS f32x4*)(km + n * 64); float g = 0.f;
#pragma unroll
        for (int j = 0; j < 16; ++j) { const f32x4 kk = kr[j]; g += qv[4 * j] * kk[0] + qv[4 * j + 1] * kk[1] + qv[4 * j + 2] * kk[2] + qv[4 * j + 3] * kk[3]; }
        top3_insert(g, n, v0, i0, v1, i1, v2, i2);
    }
    { const float pv0 = __shfl_xor(v0, 1), pv1 = __shfl_xor(v1, 1), pv2 = __shfl_xor(v2, 1); const int pi0 = __shfl_xor(i0, 1), pi1 = __shfl_xor(i1, 1), pi2 = __shfl_xor(i2, 1);
      top3_insert(pv0, pi0, v0, i0, v1, i1, v2, i2); top3_insert(pv1, pi1, v0, i0, v1, i1, v2, i2); top3_insert(pv2, pi2, v0, i0, v1, i1, v2, i2); }
    const int nvalid = c < 3 ? c : 3;
    int pos0 = 0, pos1 = 0, pos2 = 0;
    if (half == 0) { pos0 = atomicAdd((int*)&hist[i0], 1); if (nvalid > 1) pos1 = atomicAdd((int*)&hist[i1], 1); if (nvalid > 2) pos2 = atomicAdd((int*)&hist[i2], 1); }
    __syncthreads();
    if (F.tid < c) { const int n = hist[F.tid]; gbase[F.tid] = n ? (int)__hip_atomic_fetch_add(F.ctl + CW_MOBACNT + bh * 64 + F.tid, (unsigned)n, RLX_AGENT) : 0; }
    __syncthreads();
    if (half == 0) {
        unsigned short* list = (unsigned short*)(F.ws + WS_LIST) + (size_t)bh * LIST_PER_BH; const int t = c * 256 + q;
        list[moba_binoff(i0) + gbase[i0] + pos0] = (unsigned short)(t | (0 << 14));
        if (nvalid > 1) list[moba_binoff(i1) + gbase[i1] + pos1] = (unsigned short)(t | (1 << 14));
        if (nvalid > 2) list[moba_binoff(i2) + gbase[i2] + pos2] = (unsigned short)(t | (2 << 14));
    }
}

__device__ __forceinline__ void moba_stage(Frame& F, int b, int h, int j, LAS h16* K_l, LAS h16* VT_l, LAS float* BL_l) {
    const h16* Hh = (const h16*)(F.ws + WS_H);
    const h16* kb = Hh + (size_t)(b * SEQ + j * 256) * N0 + C0_MK + h * 64;
    const h16* vb = Hh + (size_t)(b * SEQ + j * 256) * N0 + C0_MV + h * 64;
#pragma unroll
    for (int i = 0; i < 4; ++i) { const int id = F.tid + i * NTHR, r = id >> 3, ch = id & 7;
        const h16x8 kv = *(const h16x8*)(kb + (size_t)r * N0 + ch * 8); *(LAS h16x8*)(K_l + r * KL_STRIDE + ch * 8) = kv;
        const h16x8 vv = *(const h16x8*)(vb + (size_t)r * N0 + ch * 8);
#pragma unroll
        for (int k = 0; k < 8; ++k) VT_l[(ch * 8 + k) * VT_STRIDE + r] = vv[k]; }
    if (F.tid < 128) BL_l[F.tid] = ((const float*)(F.ws + WS_BIASL))[h * 128 + F.tid];
}

__device__ __forceinline__ void block_scan_1024(Frame& F, int a, int b, LAS int* out, LAS int* wsum) {
    int s = a + b, inc = s;
#pragma unroll
    for (int o = 1; o < 64; o <<= 1) { const int t = __shfl_up(inc, o); if (F.lane >= o) inc += t; }
    if (F.lane == 63) wsum[F.wave] = inc;
    __syncthreads();
    int base = 0;
    for (int w = 0; w < F.wave; ++w) base += wsum[w];
    const int ex = base + inc - s;
    out[2 * F.tid] = ex; out[2 * F.tid + 1] = ex + a;
    if (F.tid == NTHR - 1) out[1024] = ex + s;
    __syncthreads();
}

__device__ __forceinline__ void moba_sparse_phase(Frame& F) {
    LAS h16* K_l = (LAS h16*)F.lds; LAS h16* VT_l = (LAS h16*)(F.lds + 36864); LAS float* BL_l = (LAS float*)(F.lds + 70656);
    LAS int* pfx = (LAS int*)(F.lds + 71680); LAS int* wsum = (LAS int*)(F.lds + 71680 + 4224);
    const gu32* cnts = F.ctl + CW_MOBACNT;
    int pa, pb; { const int b0 = 2 * F.tid, b1 = b0 + 1;
        pa = b0 < 1008 ? (int)((__hip_atomic_load(cnts + (b0 / 63) * 64 + b0 % 63, RLX_AGENT) + 511u) >> 9) : 0;
        pb = b1 < 1008 ? (int)((__hip_atomic_load(cnts + (b1 / 63) * 64 + b1 % 63, RLX_AGENT) + 511u) >> 9) : 0; }
    __syncthreads();
    block_scan_1024(F, pa, pb, pfx, wsum);
    const int NI = pfx[1008];
    const int k0 = (int)((long)F.vcu * NI / F.G), k1 = (int)((long)(F.vcu + 1) * NI / F.G);
    const h16* Hh = (const h16*)(F.ws + WS_H);
    h16* PO = (h16*)((unsigned char*)F.a->out + DO_PO); float* PML = (float*)((unsigned char*)F.a->out + DO_PML);
    int pbin = -1;
    const int q = F.lane & 15, fq = F.lane >> 4;
    for (int k = k0; k < k1; ++k) {
        int lo = 0, hi = 1007;
        while (lo < hi) { const int mid = (lo + hi + 1) >> 1; if (pfx[mid] <= k) lo = mid; else hi = mid - 1; }
        const int bin = lo, part = k - pfx[bin], bh = bin / 63, j = bin % 63, b = bh >> 3, h = bh & 7;
        if (bin != pbin) { __syncthreads(); moba_stage(F, b, h, j, K_l, VT_l, BL_l); pbin = bin; __syncthreads(); }
        const int cnt = (int)__hip_atomic_load(cnts + bh * 64 + j, RLX_AGENT);
        const unsigned short* list = (const unsigned short*)(F.ws + WS_LIST) + (size_t)bh * LIST_PER_BH + moba_binoff(j);
        const int nq = (cnt - part * 512) < 512 ? (cnt - part * 512) : 512, ntile = (nq + 15) >> 4;
        for (int tile = F.wave; tile < ntile; tile += NWAVES) {
            const int idx = part * 512 + tile * 16 + q; const bool valid = idx < cnt;
            const int entry = valid ? (int)list[idx] : ((j + 1) * 256);
            const int tq = entry & 0x3fff;
            const h16* qp = Hh + (size_t)(b * SEQ + tq) * N0 + C0_MQ + h * 64 + 8 * fq;
            const h16x8 qf0 = *(const h16x8*)qp, qf1 = *(const h16x8*)(qp + 32);
            f32x4 s[16];
#pragma unroll
            for (int kt = 0; kt < 16; ++kt) { const LAS h16* kp = K_l + (16 * kt + q) * KL_STRIDE + 8 * fq;
                f32x4 a = (f32x4){0.f, 0.f, 0.f, 0.f};
                a = __builtin_amdgcn_mfma_f32_16x16x32_f16(*(const LAS h16x8*)kp, qf0, a, 0, 0, 0);
                a = __builtin_amdgcn_mfma_f32_16x16x32_f16(*(const LAS h16x8*)(kp + 32), qf1, a, 0, 0, 0); s[kt] = a;
                if ((kt & 3) == 3) __builtin_amdgcn_sched_barrier(0); }
            const int dmin = tq - (256 * j + 255);
            float mx = -INFINITY;
            if (__all(dmin >= 113)) { const float bc = BL_l[127];
#pragma unroll
                for (int kt = 0; kt < 16; ++kt)
#pragma unroll
                    for (int r = 0; r < 4; ++r) { s[kt][r] = s[kt][r] * 0.125f + bc; mx = fmaxf(mx, s[kt][r]); }
            } else {
#pragma unroll
                for (int kt = 0; kt < 16; ++kt)
#pragma unroll
                    for (int r = 0; r < 4; ++r) { int d = tq - (256 * j + 16 * kt + 4 * fq + r); d = d > 127 ? 127 : (d < 0 ? 0 : d); s[kt][r] = s[kt][r] * 0.125f + BL_l[d]; mx = fmaxf(mx, s[kt][r]); }
            }
            mx = fmaxf(mx, __shfl_xor(mx, 16)); mx = fmaxf(mx, __shfl_xor(mx, 32));
            float l = 0.f; h16x8 pf[8];
#pragma unroll
            for (int ks = 0; ks < 8; ++ks) {
#pragma unroll
                for (int r = 0; r < 4; ++r) { const float p0 = __expf(s[2 * ks][r] - mx), p1 = __expf(s[2 * ks + 1][r] - mx); l += p0 + p1; pf[ks][r] = (h16)p0; pf[ks][4 + r] = (h16)p1; } }
            l += __shfl_xor(l, 16); l += __shfl_xor(l, 32);
            f32x4 o[4];
#pragma unroll
            for (int dt = 0; dt < 4; ++dt) { o[dt] = (f32x4){0.f, 0.f, 0.f, 0.f}; const LAS h16* vp = VT_l + (16 * dt + q) * VT_STRIDE + 4 * fq;
#pragma unroll
                for (int ks = 0; ks < 8; ++ks) { const h16x4 lo4 = *(const LAS h16x4*)(vp + 32 * ks), hi4 = *(const LAS h16x4*)(vp + 32 * ks + 16);
                    h16x8 vf; vf[0] = lo4[0]; vf[1] = lo4[1]; vf[2] = lo4[2]; vf[3] = lo4[3]; vf[4] = hi4[0]; vf[5] = hi4[1]; vf[6] = hi4[2]; vf[7] = hi4[3];
                    o[dt] = __builtin_amdgcn_mfma_f32_16x16x32_f16(pf[ks], vf, o[dt], 0, 0, 0); } }
            const int ev = valid ? entry : -1;
#pragma unroll
            for (int r = 0; r < 4; ++r) { const int e2 = __shfl(ev, 4 * fq + r);
                if (e2 >= 0) { const size_t base = (((size_t)(b * SEQ + (e2 & 0x3fff)) * 8 + h) * 3 + (e2 >> 14)) * 64 + q;
#pragma unroll
                    for (int dt = 0; dt < 4; ++dt) PO[base + 16 * dt] = (h16)o[dt][r]; } }
            if (fq == 0 && valid) { const size_t mi = (((size_t)(b * SEQ + tq) * 8 + h) * 3 + (entry >> 14)) * 2; *(f32x2*)(PML + mi) = (f32x2){mx, l}; }
        }
    }
}

__device__ __forceinline__ void moba_own_unit(Frame& F, int u) {
    const int bh = u >> 6, c = u & 63, b = bh >> 3, h = bh & 7;
    LAS h16* K_l = (LAS h16*)F.lds; LAS h16* VT_l = (LAS h16*)(F.lds + 36864); LAS float* BL_l = (LAS float*)(F.lds + 70656);
    __syncthreads(); moba_stage(F, b, h, c, K_l, VT_l, BL_l); __syncthreads();
    const h16* Hh = (const h16*)(F.ws + WS_H);
    const h16* PO = (const h16*)((unsigned char*)F.a->out + DO_PO); const float* PML = (const float*)((unsigned char*)F.a->out + DO_PML);
    h16* MX = (h16*)(F.ws + WS_MIXIN0);
    const int q = F.lane & 15, fq = F.lane >> 4; const int nvalid = c < 3 ? c : 3;
    for (int s2 = 0; s2 < 2; ++s2) {
        const int ti = s2 == 0 ? F.wave : 15 - F.wave;
        const int tl = 16 * ti + q; const size_t row = (size_t)b * SEQ + c * 256 + tl;
        const h16* qp = Hh + row * N0 + C0_MQ + h * 64 + 8 * fq;
        const h16x8 qf0 = *(const h16x8*)qp, qf1 = *(const h16x8*)(qp + 32);
        f32x4 s[16]; float mx = -INFINITY;
#pragma unroll
        for (int kt = 0; kt < 16; ++kt) {
            if (kt <= ti) { const LAS h16* kp = K_l + (16 * kt + q) * KL_STRIDE + 8 * fq;
                f32x4 a = (f32x4){0.f, 0.f, 0.f, 0.f};
                a = __builtin_amdgcn_mfma_f32_16x16x32_f16(*(const LAS h16x8*)kp, qf0, a, 0, 0, 0);
                a = __builtin_amdgcn_mfma_f32_16x16x32_f16(*(const LAS h16x8*)(kp + 32), qf1, a, 0, 0, 0);
#pragma unroll
                for (int r = 0; r < 4; ++r) { const int d = tl - (16 * kt + 4 * fq + r); const float v = a[r] * 0.125f + BL_l[d > 127 ? 127 : (d < 0 ? 0 : d)]; a[r] = d >= 0 ? v : -INFINITY; mx = fmaxf(mx, a[r]); }
                s[kt] = a;
            } else s[kt] = (f32x4){-INFINITY, -INFINITY, -INFINITY, -INFINITY};
        }
        mx = fmaxf(mx, __shfl_xor(mx, 16)); mx = fmaxf(mx, __shfl_xor(mx, 32));
        float l = 0.f; h16x8 pf[8];
#pragma unroll
        for (int ks = 0; ks < 8; ++ks) {
#pragma unroll
            for (int r = 0; r < 4; ++r) { const float p0 = __expf(s[2 * ks][r] - mx), p1 = __expf(s[2 * ks + 1][r] - mx); l += p0 + p1; pf[ks][r] = (h16)p0; pf[ks][4 + r] = (h16)p1; } }
        l += __shfl_xor(l, 16); l += __shfl_xor(l, 32);
        f32x4 o[4];
#pragma unroll
        for (int dt = 0; dt < 4; ++dt) { o[dt] = (f32x4){0.f, 0.f, 0.f, 0.f}; const LAS h16* vp = VT_l + (16 * dt + q) * VT_STRIDE + 4 * fq;
#pragma unroll
            for (int ks = 0; ks < 8; ++ks) { if (2 * ks <= ti) { const h16x4 lo4 = *(const LAS h16x4*)(vp + 32 * ks), hi4 = *(const LAS h16x4*)(vp + 32 * ks + 16);
                h16x8 vf; vf[0] = lo4[0]; vf[1] = lo4[1]; vf[2] = lo4[2]; vf[3] = lo4[3]; vf[4] = hi4[0]; vf[5] = hi4[1]; vf[6] = hi4[2]; vf[7] = hi4[3];
                o[dt] = __builtin_amdgcn_mfma_f32_16x16x32_f16(pf[ks], vf, o[dt], 0, 0, 0); } } }
        float mr[3], lr[3]; float Mx = mx;
#pragma unroll
        for (int k = 0; k < 3; ++k) { if (k < nvalid) { const f32x2 t = *(const f32x2*)(PML + ((row * 8 + h) * 3 + k) * 2); mr[k] = t[0]; lr[k] = t[1]; Mx = fmaxf(Mx, mr[k]); } else { mr[k] = -INFINITY; lr[k] = 0.f; } }
        const float wo = __expf(mx - Mx); float den = l * wo; float wk[3];
#pragma unroll
        for (int k = 0; k < 3; ++k) { wk[k] = k < nvalid ? __expf(mr[k] - Mx) : 0.f; den += lr[k] * wk[k]; }
        const float inv = 1.f / den;
#pragma unroll
        for (int r = 0; r < 4; ++r) { const int q2 = 4 * fq + r; const float wo2 = __shfl(wo, q2) , inv2 = __shfl(inv, q2); const float w0 = __shfl(wk[0], q2), w1 = __shfl(wk[1], q2), w2 = __shfl(wk[2], q2);
            const size_t row2 = (size_t)b * SEQ + c * 256 + 16 * ti + q2; const h16* pp = PO + ((row2 * 8 + h) * 3) * 64 + q;
#pragma unroll
            for (int dt = 0; dt < 4; ++dt) { float v = o[dt][r] * wo2;
                if (nvalid > 0) v += (float)pp[16 * dt] * w0;
                if (nvalid > 1) v += (float)pp[64 + 16 * dt] * w1;
                if (nvalid > 2) v += (float)pp[128 + 16 * dt] * w2;
                MX[row2 * DM + h * 64 + 16 * dt + q] = (h16)(v * inv2); } }
    }
}

constexpr int GS = 72;
template <int MIX> struct GlaCfg;
template <> struct GlaCfg<0> { static constexpr int PITCH = N0, CQ = C0_GQ, CK = C0_GK, CV = C0_GV, CG = C0_GR, OUTC = 512; };
template <> struct GlaCfg<1> { static constexpr int PITCH = N1, CQ = C1_HQ, CK = C1_HF, CV = C1_HI, CG = C1_HG, OUTC = 0; };
template <> struct GlaCfg<2> { static constexpr int PITCH = N1, CQ = C1_RQ, CK = C1_RK, CV = C1_RV, CG = C1_RG, OUTC = 512; };

__device__ __forceinline__ float logsigmoid_f(float z) { return fminf(z, 0.f) - log1pf(expf(-fabsf(z))); }

template <int MIX>
__device__ __forceinline__ void gla_load(Frame& F, int b, int head, int n, float (&q)[8], float (&k)[8], float (&bb)[8], float& blast, LAS float* part, bool need_q) {
    typedef GlaCfg<MIX> C; const Args& A = *F.a;
    const h16* Hh = (const h16*)(F.ws + WS_H); const int d = F.lane, w = F.wave;
    const size_t row0 = (size_t)b * SEQ + n * 64 + 8 * w; const int col = head * 64 + d;
    float la[8];
    if (MIX == 0) {
        float wg[16];
#pragma unroll
        for (int r = 0; r < 16; ++r) wg[r] = A.in[I_GLAWG][r * 256 + col];
        const float bg = A.in[I_GLABG][col];
#pragma unroll
        for (int i = 0; i < 8; ++i) { const h16* hr = Hh + (row0 + i) * C::PITCH;
            q[i] = need_q ? (float)hr[C::CQ + col] * 0.125f : 0.f; k[i] = (float)hr[C::CK + col];
            const h16x8 g0 = *(const h16x8*)(hr + C0_GA), g1 = *(const h16x8*)(hr + C0_GA + 8); float z = bg;
#pragma unroll
            for (int r = 0; r < 8; ++r) z += (float)g0[r] * wg[r] + (float)g1[r] * wg[8 + r];
            la[i] = logsigmoid_f(z) * (1.f / 16.f); }
    } else if (MIX == 1) {
        const float g0 = A.in[I_HGAMMA][col], g1 = A.in[I_HGAMMA][256 + col]; const float lb = 1.f / (1.f + expf(g0 - g1));
#pragma unroll
        for (int i = 0; i < 8; ++i) { const h16* hr = Hh + (row0 + i) * C::PITCH;
            q[i] = need_q ? (float)hr[C::CQ + col] : 0.f; const float hf = (float)hr[C::CK + col];
            const float f = lb + (1.f - lb) / (1.f + expf(-hf)); la[i] = logf(f); k[i] = 1.f - f; }
    } else {
        const float lg = log1pf(-exp2f(-5.f - (float)head));
        const float* rc = (const float*)(F.ws + WS_ROPE); const float* rs = rc + SEQ * 32;
#pragma unroll
        for (int i = 0; i < 8; ++i) { const h16* hr = Hh + (row0 + i) * C::PITCH; const int pos = n * 64 + 8 * w + i;
            const float cs = rc[pos * 32 + (d & 31)], sn = rs[pos * 32 + (d & 31)];
            const float xq = need_q ? (float)hr[C::CQ + col] : 0.f, xk = (float)hr[C::CK + col];
            const float pq = __shfl_xor(xq, 32), pk = __shfl_xor(xk, 32);
            q[i] = d < 32 ? xq * cs - pq * sn : pq * sn + xq * cs;
            k[i] = (d < 32 ? xk * cs - pk * sn : pk * sn + xk * cs) * 0.125f;
            la[i] = lg; }
    }
    float c = 0.f;
#pragma unroll
    for (int i = 0; i < 8; ++i) { c += la[i]; bb[i] = c; }
    part[w * 64 + d] = c;
    __syncthreads();
    float pre = 0.f, tot = 0.f;
#pragma unroll
    for (int w2 = 0; w2 < 8; ++w2) { const float pv = part[w2 * 64 + d]; tot += pv; if (w2 < w) pre += pv; }
#pragma unroll
    for (int i = 0; i < 8; ++i) bb[i] += pre;
    blast = tot;
}
template <int MIX>
__device__ __forceinline__ void gla_stage_vt(Frame& F, int b, int head, int n, LAS h16* Vt_l) {
    typedef GlaCfg<MIX> C; const h16* Hh = (const h16*)(F.ws + WS_H);
#pragma unroll
    for (int i = 0; i < 2; ++i) { const int id = F.tid + i * NTHR, r = id >> 4, ch = id & 15;
        const h16x8 v = *(const h16x8*)(Hh + ((size_t)b * SEQ + n * 64 + r) * C::PITCH + C::CV + head * 128 + ch * 8);
#pragma unroll
        for (int k2 = 0; k2 < 8; ++k2) Vt_l[(ch * 8 + k2) * GS + r] = v[k2]; }
}

template <int MIX>
__device__ __forceinline__ void gla_a_unit(Frame& F, int gidx, int b, int head, int n, h16* UT, float* DV) {
    LAS h16* KT_l = (LAS h16*)F.lds;
    LAS h16* Vt_l = (LAS h16*)(F.lds + 9216);
    LAS float* part = (LAS float*)(F.lds + 9216 + 18432);
    float q[8], k[8], bb[8], blast;
    __syncthreads();
    gla_load<MIX>(F, b, head, n, q, k, bb, blast, part, false);
    { h16x8 kv;
#pragma unroll
      for (int i = 0; i < 8; ++i) kv[i] = (h16)(k[i] * __expf(blast - bb[i]));
      *(LAS h16x8*)(KT_l + F.lane * GS + 8 * F.wave) = kv; }
    gla_stage_vt<MIX>(F, b, head, n, Vt_l);
    if (F.wave == 0) DV[((size_t)gidx * 256 + n) * 64 + F.lane] = __expf(blast);
    __syncthreads();
    const int fr = F.lane & 15, fq = F.lane >> 4, w = F.wave;
    const h16x8 a0 = *(const LAS h16x8*)(Vt_l + (16 * w + fr) * GS + 8 * fq), a1 = *(const LAS h16x8*)(Vt_l + (16 * w + fr) * GS + 32 + 8 * fq);
    h16* up = UT + ((size_t)gidx * 256 + n) * 8192;
#pragma unroll
    for (int dt = 0; dt < 4; ++dt) {
        const h16x8 b0 = *(const LAS h16x8*)(KT_l + (16 * dt + fr) * GS + 8 * fq), b1 = *(const LAS h16x8*)(KT_l + (16 * dt + fr) * GS + 32 + 8 * fq);
        f32x4 acc = (f32x4){0.f, 0.f, 0.f, 0.f};
        acc = __builtin_amdgcn_mfma_f32_16x16x32_f16(a0, b0, acc, 0, 0, 0);
        acc = __builtin_amdgcn_mfma_f32_16x16x32_f16(a1, b1, acc, 0, 0, 0);
#pragma unroll
        for (int r = 0; r < 4; ++r) up[(16 * w + 4 * fq + r) * 64 + 16 * dt + fr] = (h16)acc[r];
    }
}

__device__ __forceinline__ void gla_scan_unit(Frame& F, int u, const h16* UT, const float* DV, h16* ST) {
    const int gidx = u >> 2, e = (u & 3) * 32 + (F.tid >> 4), d4 = (F.tid & 15) * 4;
    const h16* up = UT + (size_t)gidx * 256 * 8192 + e * 64 + d4; h16* sp = ST + (size_t)gidx * 256 * 8192 + e * 64 + d4; const float* dp = DV + (size_t)gidx * 256 * 64 + d4;
    f32x4 S = (f32x4){0.f, 0.f, 0.f, 0.f};
    for (int nb = 0; nb < 256; nb += 8) {
        h16x4 uu[8]; f32x4 dd[8];
#pragma unroll
        for (int j = 0; j < 8; ++j) { uu[j] = *(const h16x4*)(up + (size_t)(nb + j) * 8192); dd[j] = *(const f32x4*)(dp + (nb + j) * 64); }
#pragma unroll
        for (int j = 0; j < 8; ++j) { h16x4 o; o[0] = (h16)S[0]; o[1] = (h16)S[1]; o[2] = (h16)S[2]; o[3] = (h16)S[3]; *(h16x4*)(sp + (size_t)(nb + j) * 8192) = o;
#pragma unroll
            for (int c = 0; c < 4; ++c) S[c] = S[c] * dd[j][c] + (float)uu[j][c]; }
    }
}

template <int MIX>
__device__ __forceinline__ void gla_c_unit(Frame& F, int gidx, int b, int head, int n, const h16* ST, h16* MX, const float* gw) {
    typedef GlaCfg<MIX> C;
    LAS h16* Qb_l = (LAS h16*)F.lds;
    LAS __bf16* QI_l = (LAS __bf16*)(F.lds + 9216);
    LAS __bf16* KI_l = (LAS __bf16*)(F.lds + 18432);
    LAS h16* P_l = (LAS h16*)(F.lds + 55296);
    LAS h16* Vt_l = (LAS h16*)(F.lds + 64512);
    LAS float* part = (LAS float*)(F.lds + 82944);
    LAS float* rI = (LAS float*)(F.lds + 84992);
    LAS float* stats = (LAS float*)(F.lds + 86016);
    float q[8], k[8], bb[8], blast;
    __syncthreads();
    gla_load<MIX>(F, b, head, n, q, k, bb, blast, part, true);
    const int d = F.lane, w = F.wave;
    if ((w & 1) == 0) rI[(w >> 1) * 64 + d] = bb[0];
    { unsigned zz = 0u; asm volatile("" : "+v"(zz)); const u32x4 z4 = (u32x4){zz, zz, zz, zz}; LAS u32x4* pz = (LAS u32x4*)P_l; pz[F.tid] = z4; if (F.tid < 64) pz[512 + F.tid] = z4; }
    gla_stage_vt<MIX>(F, b, head, n, Vt_l);
    __syncthreads();
    { const int I = w >> 1; float r[4];
#pragma unroll
      for (int I2 = 0; I2 < 4; ++I2) r[I2] = rI[I2 * 64 + d];
#pragma unroll
      for (int i = 0; i < 8; ++i) { const int t = 8 * w + i;
          Qb_l[t * GS + d] = (h16)(q[i] * __expf(bb[i]));
          QI_l[t * GS + d] = (__bf16)(q[i] * __expf(bb[i] - r[I]));
#pragma unroll
          for (int I2 = 0; I2 < 4; ++I2) if (I2 >= I) KI_l[(I2 * 64 + t) * GS + d] = (__bf16)(k[i] * __expf(fminf(r[I2] - bb[i], 80.f))); } }
    __syncthreads();
    const int fr = F.lane & 15, fq = F.lane >> 4;
    for (int p = w; p < 10; p += 8) {
        const int I = p >= 6 ? 3 : (p >= 3 ? 2 : (p >= 1 ? 1 : 0)), J = p - (I * (I + 1)) / 2;
        const LAS __bf16* ap = QI_l + (16 * I + fr) * GS + 8 * fq; const LAS __bf16* bp = KI_l + (I * 64 + 16 * J + fr) * GS + 8 * fq;
        f32x4 acc = (f32x4){0.f, 0.f, 0.f, 0.f};
        acc = __builtin_amdgcn_mfma_f32_16x16x32_bf16(*(const LAS b16x8*)ap, *(const LAS b16x8*)bp, acc, 0, 0, 0);
        acc = __builtin_amdgcn_mfma_f32_16x16x32_bf16(*(const LAS b16x8*)(ap + 32), *(const LAS b16x8*)(bp + 32), acc, 0, 0, 0);
#pragma unroll
        for (int r = 0; r < 4; ++r) { const int tl = 4 * fq + r; const float v = (I == J && fr > tl) ? 0.f : acc[r]; P_l[(16 * I + tl) * GS + 16 * J + fr] = (h16)v; }
    }
    __syncthreads();
    const int tt = w >> 1, eh = w & 1;
    const h16x8 p0 = *(const LAS h16x8*)(P_l + (16 * tt + fr) * GS + 8 * fq), p1 = *(const LAS h16x8*)(P_l + (16 * tt + fr) * GS + 32 + 8 * fq);
    const h16x8 qb0 = *(const LAS h16x8*)(Qb_l + (16 * tt + fr) * GS + 8 * fq), qb1 = *(const LAS h16x8*)(Qb_l + (16 * tt + fr) * GS + 32 + 8 * fq);
    const h16* sp = ST + ((size_t)gidx * 256 + n) * 8192;
    f32x4 o[4]; float s1[4] = {0.f, 0.f, 0.f, 0.f}, s2[4] = {0.f, 0.f, 0.f, 0.f};
#pragma unroll
    for (int et = 0; et < 4; ++et) { const int e0 = 64 * eh + 16 * et;
        const h16x8 v0 = *(const LAS h16x8*)(Vt_l + (e0 + fr) * GS + 8 * fq), v1 = *(const LAS h16x8*)(Vt_l + (e0 + fr) * GS + 32 + 8 * fq);
        const h16x8 t0 = *(const h16x8*)(sp + (e0 + fr) * 64 + 8 * fq), t1 = *(const h16x8*)(sp + (e0 + fr) * 64 + 32 + 8 * fq);
        f32x4 acc = (f32x4){0.f, 0.f, 0.f, 0.f};
        acc = __builtin_amdgcn_mfma_f32_16x16x32_f16(p0, v0, acc, 0, 0, 0);
        acc = __builtin_amdgcn_mfma_f32_16x16x32_f16(p1, v1, acc, 0, 0, 0);
        acc = __builtin_amdgcn_mfma_f32_16x16x32_f16(qb0, t0, acc, 0, 0, 0);
        acc = __builtin_amdgcn_mfma_f32_16x16x32_f16(qb1, t1, acc, 0, 0, 0);
        o[et] = acc;
#pragma unroll
        for (int r = 0; r < 4; ++r) { s1[r] += acc[r]; s2[r] += acc[r] * acc[r]; } }
#pragma unroll
    for (int r = 0; r < 4; ++r) {
#pragma unroll
        for (int x = 1; x < 16; x <<= 1) { s1[r] += __shfl_xor(s1[r], x); s2[r] += __shfl_xor(s2[r], x); }
        if (fr == 0) { const int t = 16 * tt + 4 * fq + r; stats[(t * 2 + eh) * 2] = s1[r]; stats[(t * 2 + eh) * 2 + 1] = s2[r]; } }
    __syncthreads();
    const h16* Hh = (const h16*)(F.ws + WS_H);
#pragma unroll
    for (int r = 0; r < 4; ++r) { const int t = 16 * tt + 4 * fq + r;
        const float a1 = stats[(t * 2) * 2] + stats[(t * 2 + 1) * 2], a2 = stats[(t * 2) * 2 + 1] + stats[(t * 2 + 1) * 2 + 1];
        float mean = 0.f, rstd;
        if (MIX == 2) { mean = a1 * (1.f / 128.f); const float var = fmaxf(a2 * (1.f / 128.f) - mean * mean, 0.f); rstd = 1.f / sqrtf(var + HEAD_EPS); }
        else rstd = 1.f / sqrtf(a2 * (1.f / 128.f) + HEAD_EPS);
        const size_t row = (size_t)b * SEQ + n * 64 + t;
#pragma unroll
        for (int et = 0; et < 4; ++et) { const int e = 64 * eh + 16 * et + fr; const float g = (float)Hh[row * C::PITCH + C::CG + head * 128 + e];
            const float y = (o[et][r] - mean) * rstd * gw[head * 128 + e] * pg8::silu_f(g);
            MX[row * DM + C::OUTC + head * 128 + e] = (h16)y; } }
}

__device__ __forceinline__ void p_xconv_gather(Frame& F) {
    const Args& A = *F.a; unsigned char* ws = F.ws;
    LAS float* scr = (LAS float*)(F.lds + F.wave * 16384);
    LAS int* ps_l = (LAS int*)(F.lds + LDS_X_OFF);
    const int gw = F.vcu * NWAVES + F.wave, NGW = F.G * NWAVES;
    if (F.tid == 0) {
        int acc = 0; int* meta = (int*)(ws + WS_META);
        for (int e = 0; e < 8; ++e) { const int c = (int)__hip_atomic_load(F.ctl + CW_MOECNT + e, RLX_AGENT); ps_l[e] = acc;
            if (blockIdx.x == 0) { meta[e] = c; meta[8 + e] = acc; const int np = (c + 255) >> 8; for (int p = 0; p < np; ++p) meta[32 + (acc >> 8) + p] = e; }
            acc += ((c + 255) >> 8) << 8; }
        if (blockIdx.x == 0) meta[16] = acc >> 8;
    }
    __syncthreads();
    { const h16* xa = (const h16*)(ws + WS_XA); h16* xs = (h16*)(ws + WS_XS); int* route = (int*)(ws + WS_ROUTE); int* rowslot = (int*)(ws + WS_ROWSLOT);
      for (int t = gw; t < M; t += NGW) { const int* rr = route + (size_t)t * 8; const int r0 = ps_l[rr[0]] + rr[1], r1 = ps_l[rr[2]] + rr[3];
          const h16x8 a = *(const h16x8*)(xa + (size_t)t * DM + F.lane * 8), b = *(const h16x8*)(xa + (size_t)t * DM + 512 + F.lane * 8);
          *(h16x8*)(xs + (size_t)r0 * DM + F.lane * 8) = a; *(h16x8*)(xs + (size_t)r0 * DM + 512 + F.lane * 8) = b;
          *(h16x8*)(xs + (size_t)r1 * DM + F.lane * 8) = a; *(h16x8*)(xs + (size_t)r1 * DM + 512 + F.lane * 8) = b;
          if (F.lane == 0) { rowslot[r0] = 2 * t; rowslot[r1] = 2 * t + 1; } } }
    constexpr int TI = 1792, NT = 8 * 3 * TI;
    for (int it = gw; it < NT; it += NGW) {
        const int e = it / (3 * TI), r = it % (3 * TI), which = r / TI, item = r % TI;
        if (which == 0) transpose_item(A.in[I_XW1] + (size_t)e * 1024 * FE, FE, (h16*)(ws + WS_E13) + (size_t)e * 7168 * 1024, 1024, 2, scr, item, F.lane);
        else if (which == 1) transpose_item(A.in[I_XW3] + (size_t)e * 1024 * FE, FE, (h16*)(ws + WS_E13) + (size_t)e * 7168 * 1024, 1024, 3, scr, item, F.lane);
        else transpose_item(A.in[I_XW2] + (size_t)e * FE * 1024, 1024, (h16*)(ws + WS_E2) + (size_t)e * 1024 * FE, FE, 0, scr, item, F.lane);
    }
}

constexpr int NPH = 31;
__global__ void __launch_bounds__(NTHR, 2) hyb_fwd(Args args) {
    extern __shared__ __attribute__((aligned(16))) unsigned char lds_raw[];
    Frame F;
    F.lds = (LAS unsigned char*)lds_raw; F.tid = threadIdx.x; F.lane = F.tid & 63; F.wave = __builtin_amdgcn_readfirstlane(F.tid >> 6);
    F.G = gridDim.x; { const int bx = blockIdx.x; F.vcu = (F.G % 8 == 0) ? (bx % 8) * (F.G / 8) + bx / 8 : bx; }
    F.ws = args.ws; F.ctl = (gu32*)(args.ws + WS_CTL); F.a = &args;
    if (F.tid < 64) ((LAS unsigned*)(F.lds + LDSCTL_OFF))[F.tid] = 0u;
    __syncthreads();
    const int lo = args.ph_lo, hi = args.ph_hi;
    XcdBarrier bar; bar.bar = (unsigned*)(F.ctl + CW_BAR); bar.x = 0; bar.st = (volatile LAS unsigned*)(F.lds + LDSCTL_OFF + 32);
    if (hi - lo > 1) bar = xcd_barrier_post((unsigned*)(F.ctl + CW_BAR), (volatile LAS unsigned*)(F.lds + LDSCTL_OFF + 32));
#ifndef PHMASK
#define PHMASK 0x7fffffffull
#endif
#define IN(k) (((PHMASK >> ((k) >= 20 && (k) < 28 ? 20 + ((k) & 1) : (k))) & 1ull) && lo <= (k) && (k) < hi)
#define SEAM(k) do { if (IN(k) && IN((k) + 1)) xcd_barrier(bar); } while (0)
#define XA ((h16*)(F.ws + WS_XA))
#define XB ((h16*)(F.ws + WS_XB))
#define Hb ((h16*)(F.ws + WS_H))
#define Yb ((h16*)(F.ws + WS_Y))
    const int cid = (int)blockIdx.x;

    if (IN(0)) { launder(F); p_prologue(F); }
    SEAM(0);
#pragma unroll 1
    for (int L = 0; L < 2; ++L) {
        const int p_in = L ? 13 : 1, p_out = L ? 17 : 6, p_lnb = L ? 28 : 10;
#define Xin (L ? XB : XA)
#define Xmid (L ? XA : XB)
#define Xffn (L ? XB : XA)
#define MXb ((h16*)(F.ws + (L ? WS_MIXIN1 : WS_MIXIN0)))
        if (IN(p_in)) { launder(F); const int N = L ? N1 : N0;
            pg8::Gemm g{Xin, (const h16*)(F.ws + (L ? WS_WIN1 : WS_WIN0)), 1024}; pg8::StaticOrder S; S.init(M, N, F.G, cid);
            pg8::EpiStoreH E{Hb, N};
            pg8::gemm_phase<pg8::EpiStoreH, pg8::StaticOrder, true>(F.lds, g, S, E); }
        SEAM(p_in);
        if (L == 0) {
            if (IN(2)) { launder(F); for (int u = F.vcu; u < 128 + 2048; u += F.G) { if (u < 128) moba_kmean_unit(F, u); else { const int v = u - 128, gi = v >> 8, n = v & 255; gla_a_unit<0>(F, gi, gi >> 2, gi & 3, n, (h16*)(F.ws + WS_U0), (float*)(F.ws + WS_DV0)); } } }
            SEAM(2);
            if (IN(3)) { launder(F); for (int u = F.vcu; u < 32 + 1008; u += F.G) { if (u < 32) gla_scan_unit(F, u, (const h16*)(F.ws + WS_U0), (const float*)(F.ws + WS_DV0), (h16*)(F.ws + WS_ST0)); else moba_select_unit(F, u - 32); } }
            SEAM(3);
            if (IN(4)) { launder(F); moba_sparse_phase(F); }
            SEAM(4);
            if (IN(5)) { launder(F); for (int u = F.vcu; u < 1024 + 2048; u += F.G) { if (u < 1024) moba_own_unit(F, u); else { const int v = u - 1024, gi = v >> 8, n = v & 255; gla_c_unit<0>(F, gi, gi >> 2, gi & 3, n, (const h16*)(F.ws + WS_ST0), MXb, args.in[I_GLAN]); } } }
            SEAM(5);
        } else {
            if (IN(14)) { launder(F); for (int u = F.vcu; u < 4096; u += F.G) { const int gi = u >> 8, n = u & 255, bh = gi & 7;
                if (gi < 8) gla_a_unit<1>(F, gi, bh >> 2, bh & 3, n, (h16*)(F.ws + WS_U1), (float*)(F.ws + WS_DV1)); else gla_a_unit<2>(F, gi, bh >> 2, bh & 3, n, (h16*)(F.ws + WS_U1), (float*)(F.ws + WS_DV1)); } }
            SEAM(14);
            if (IN(15)) { launder(F); for (int u = F.vcu; u < 64; u += F.G) gla_scan_unit(F, u, (const h16*)(F.ws + WS_U1), (const float*)(F.ws + WS_DV1), (h16*)(F.ws + WS_ST1)); }
            SEAM(15);
            if (IN(16)) { launder(F); for (int u = F.vcu; u < 4096; u += F.G) { const int gi = u >> 8, n = u & 255, bh = gi & 7;
                if (gi < 8) gla_c_unit<1>(F, gi, bh >> 2, bh & 3, n, (const h16*)(F.ws + WS_ST1), MXb, args.in[I_HNORM]); else gla_c_unit<2>(F, gi, bh >> 2, bh & 3, n, (const h16*)(F.ws + WS_ST1), MXb, args.in[I_RNORM]); } }
            SEAM(16);
        }
        if (IN(p_out)) { launder(F); pg8::Gemm g{MXb, (const h16*)(F.ws + (L ? WS_WOUT1 : WS_WOUT0)), 1024}; pg8::StaticOrder S; S.init(M, 1024, F.G, cid);
            pg8::EpiResid E{Yb, Xin};
            pg8::gemm_phase<pg8::EpiResid, pg8::StaticOrder, true>(F.lds, g, S, E); }
        SEAM(p_out);
        if (IN(p_out + 1)) { launder(F); __syncthreads();
            if (L == 0) ln_phase<0>(F, Yb, args.in[I_LMG], args.in[I_LMB], Xmid, nullptr, nullptr);
            else ln_phase<1>(F, Yb, args.in[I_LMG] + 1024, args.in[I_LMB] + 1024, Xmid, nullptr, nullptr); }
        SEAM(p_out + 1);
        if (L == 0) {
            if (IN(8)) { launder(F); pg8::Gemm g{Xmid, (const h16*)(F.ws + WS_W13_0), 1024}; pg8::StaticOrder S; S.init(M, 2 * FDP, F.G, cid);
                pg8::EpiSwiGLU E{(h16*)(F.ws + WS_HID), FDP};
                pg8::gemm_phase<pg8::EpiSwiGLU, pg8::StaticOrder, true>(F.lds, g, S, E); }
            SEAM(8);
            if (IN(9)) { launder(F); pg8::Gemm g{(const h16*)(F.ws + WS_HID), (const h16*)(F.ws + WS_W2_0), FDP}; pg8::StaticOrder S; S.init(M, 1024, F.G, cid);
                pg8::EpiResid E{Yb, Xmid};
                pg8::gemm_phase<pg8::EpiResid, pg8::StaticOrder, true>(F.lds, g, S, E); }
            SEAM(9);
        } else {
            if (IN(19)) { launder(F); __syncthreads(); p_xconv_gather(F); }
            SEAM(19);
#define meta ((const int*)(F.ws + WS_META))
#pragma unroll 1
            for (int q = 0; q < MOE_PASSES; ++q) {
                const int pu = 20 + 2 * q;
                if (IN(pu)) { launder(F); const int PT = __builtin_amdgcn_readfirstlane(meta[16]); const int P0 = MOE_PPP * q, P1 = (P0 + MOE_PPP) < PT ? (P0 + MOE_PPP) : PT;
                    pg8::Gemm g{(const h16*)(F.ws + WS_XS), (const h16*)(F.ws + WS_E13), 1024}; pg8::MoeOrder S; S.init(P0, P1, 28, F.G, cid, 1, meta + 32);
                    pg8::EpiSwiGLU E{(h16*)(F.ws + WS_HQ), FE};
                    pg8::gemm_phase<pg8::EpiSwiGLU, pg8::MoeOrder, true>(F.lds, g, S, E); }
                SEAM(pu);
                if (IN(pu + 1)) { launder(F); const int PT = __builtin_amdgcn_readfirstlane(meta[16]); const int P0 = MOE_PPP * q, P1 = (P0 + MOE_PPP) < PT ? (P0 + MOE_PPP) : PT;
                    pg8::Gemm g{(const h16*)(F.ws + WS_HQ), (const h16*)(F.ws + WS_E2), FE}; pg8::MoeOrder S; S.init(P0, P1, 4, F.G, cid, 0, meta + 32);
                    pg8::EpiMoeDown E{(h16*)args.out, (const int*)(F.ws + WS_ROWSLOT), meta};
                    pg8::gemm_phase<pg8::EpiMoeDown, pg8::MoeOrder, true>(F.lds, g, S, E); }
                SEAM(pu + 1);
            }
        }
        if (IN(p_lnb)) { launder(F); __syncthreads();
            if (L == 0) ln_phase<0>(F, Yb, args.in[I_LFG], args.in[I_LFB], Xffn, nullptr, nullptr);
            else ln_phase<2>(F, nullptr, args.in[I_LFG] + 1024, args.in[I_LFB] + 1024, Xffn, Xmid, (const h16*)args.out); }
        SEAM(p_lnb);
        if (IN(p_lnb + 1)) { launder(F); pg8::Gemm g{(const h16*)(F.ws + WS_PH) + (size_t)L * M * PLE, (const h16*)(F.ws + (L ? WS_WP1 : WS_WP0)), PLE}; pg8::StaticOrder S; S.init(M, 1024, F.G, cid);
            pg8::EpiStoreH E{(h16*)(F.ws + WS_PP), 1024};
            pg8::gemm_phase<pg8::EpiStoreH, pg8::StaticOrder, true>(F.lds, g, S, E); }
        SEAM(p_lnb + 1);
        if (IN(p_lnb + 2)) { launder(F); pg8::Gemm g{Xffn, (const h16*)(F.ws + (L ? WS_WG1 : WS_WG0)), 1024}; pg8::StaticOrder S; S.init(M, 1024, F.G, cid);
            pg8::EpiPle E{Xffn, (const h16*)(F.ws + WS_PP), L ? XA : XB, args.out, L};
            pg8::gemm_phase<pg8::EpiPle, pg8::StaticOrder, true>(F.lds, g, S, E); }
        if (L == 0) SEAM(12);
    }
#undef XA
#undef XB
#undef Hb
#undef Yb
#undef Xin
#undef Xmid
#undef Xffn
#undef MXb
#undef meta
#undef IN
#undef SEAM
}

#ifndef MK_PER_PHASE
#define MK_PER_PHASE 1
#endif
extern "C" void kernel_launch(void* const* d_in, const int* in_sizes, int n_in, void* d_out, int out_size, void* d_ws, size_t ws_size, hipStream_t stream) {
    static int grid = 0;
    if (grid == 0) {
        if (n_in != 27 || in_sizes[0] != M * DM || out_size != M * DM || ws_size < WS_END) { fprintf(stderr, "kernel_launch: unexpected shapes (n_in %d, in0 %d, out %d, ws %zu); nothing launched\n", n_in, n_in > 0 ? in_sizes[0] : -1, out_size, ws_size); grid = -1; return; }
        int dev = 0, cus = 0, per_cu = 0;
        if (hipGetDevice(&dev) != hipSuccess || hipDeviceGetAttribute(&cus, hipDeviceAttributeMultiprocessorCount, dev) != hipSuccess) { grid = -1; return; }
        if (hipFuncSetAttribute((const void*)hyb_fwd, hipFuncAttributeMaxDynamicSharedMemorySize, LDS_BYTES) != hipSuccess) { fprintf(stderr, "kernel_launch: hipFuncSetAttribute failed\n"); grid = -1; return; }
        if (hipOccupancyMaxActiveBlocksPerMultiprocessor(&per_cu, (const void*)hyb_fwd, NTHR, LDS_BYTES) != hipSuccess || per_cu < 1) fprintf(stderr, "kernel_launch: occupancy query reports %d\n", per_cu);
        (void)hipGetLastError();
        grid = cus;
    }
    if (grid < 0) return;
    if (hipMemsetAsync((char*)d_ws + WS_CTL, 0, CTL_ZERO_BYTES, stream) != hipSuccess) return;
    Args a{};
    for (int i = 0; i < 27; ++i) a.in[i] = (const float*)d_in[i];
    a.out = (float*)d_out; a.ws = (unsigned char*)d_ws;
#if MK_PER_PHASE
    for (int ph = 0; ph < NPH; ++ph) { a.ph_lo = ph; a.ph_hi = ph + 1; hipLaunchKernelGGL(hyb_fwd, dim3(grid), dim3(NTHR), LDS_BYTES, stream, a); }
#else
    a.ph_lo = 0; a.ph_hi = NPH; hipLaunchKernelGGL(hyb_fwd, dim3(grid), dim3(NTHR), LDS_BYTES, stream, a);
#endif
}
```

```cpp
#include <hip/hip_runtime.h>
#include <cstdio>
#include <cstdint>

#define LAS __attribute__((address_space(3)))
#define GAS __attribute__((address_space(1)))
typedef _Float16 h16;
typedef _Float16 h16x8 __attribute__((ext_vector_type(8)));
typedef _Float16 h16x4 __attribute__((ext_vector_type(4)));
typedef _Float16 h16x2 __attribute__((ext_vector_type(2)));
typedef __bf16 b16x8 __attribute__((ext_vector_type(8)));
typedef float f32x4 __attribute__((ext_vector_type(4)));
typedef float f32x2 __attribute__((ext_vector_type(2)));
typedef unsigned u32x4 __attribute__((ext_vector_type(4)));
typedef unsigned u32x2 __attribute__((ext_vector_type(2)));
typedef GAS unsigned gu32;
#define RLX_AGENT __ATOMIC_RELAXED, __HIP_MEMORY_SCOPE_AGENT
#define LDS_WAIT() asm volatile("s_waitcnt lgkmcnt(0)" ::: "memory")
#define VM_WAIT() asm volatile("s_waitcnt vmcnt(0)" ::: "memory")

constexpr int BATCH = 2, SEQ = 16384, DM = 1024, M = BATCH * SEQ;
constexpr int NWAVES = 8, NTHR = 512;
constexpr float DN_ALPHA = 1.4142135623730951f;
constexpr float LN_EPS = 1e-5f, HEAD_EPS = 1e-6f;
constexpr int N0 = 3328;
constexpr int N1 = 3072;
constexpr int C0_MQ = 0, C0_MK = 512, C0_MV = 1024, C0_GQ = 1536, C0_GK = 1792, C0_GV = 2048, C0_GR = 2560, C0_GA = 3072;
constexpr int C1_HQ = 0, C1_HF = 256, C1_HI = 512, C1_HG = 1024, C1_RQ = 1536, C1_RK = 1792, C1_RV = 2048, C1_RG = 2560;
constexpr int FD = 2752, FDP = 2816;
constexpr int FE = 3584, NEXP = 8;
constexpr int PLE = 256;
constexpr int MOE_PANELS = 264;
constexpr int MOE_PASSES = 4, MOE_PPP = 66;

namespace pg8 {
constexpr int BM = 256, BK = 64, HALF = 128, HTB = HALF * BK * 2, STAGE_BYTES = 8 * HTB, NXCD = 8, WGM = 8;
__host__ __device__ __forceinline__ int lds_byte(int r, int c) { const int st = (r >> 4) * 2 + (c >> 5), rr = r & 15, cc = c & 31, ob = rr * 64 + cc * 2; return st * 1024 + (ob ^ (((ob >> 9) & 1) << 5)); }
__host__ __device__ __forceinline__ void stage_rc(int b, int& R, int& C) { const int st = b / 1024, sb = b % 1024, swz = sb ^ (((sb >> 9) & 1) << 5); R = (st >> 1) * 16 + swz / 64; C = (st & 1) * 32 + (swz % 64) / 2; }
__host__ __device__ __forceinline__ int perm32(int rho) { const int n = rho >> 4, i = rho & 15; return 8 * (i >> 2) + 4 * n + (i & 3); }

struct Unit { int pa, pb, pm, pn; };
struct Gemm { const h16* A; const h16* Bt; int K; };

struct StaticOrder {
    int nM, nN, nwg, G, c;
    __device__ void init(int Mrows, int N, int G_, int c_) { nM = Mrows / BM; nN = N / BM; nwg = nM * nN; G = G_; c = c_; }
    __device__ bool next(int i, Unit& u) const {
        const long L = (long)i * G + c; if (L >= nwg) return false;
        int wgid = (int)L; { const int q = nwg / NXCD, r = nwg % NXCD, xcd = wgid % NXCD, off = wgid / NXCD; wgid = (xcd < r ? xcd * (q + 1) : r * (q + 1) + (xcd - r) * q) + off; }
        const int nig = WGM * nN, gid = wgid / nig, fm = gid * WGM, gsz = (nM - fm) < WGM ? (nM - fm) : WGM;
        u.pm = fm + ((wgid % nig) % gsz); u.pn = (wgid % nig) / gsz; u.pa = u.pm; u.pb = u.pn; return true;
    }
};
struct MoeOrder {
    int P0, nM, nN, nwg, G, c, up; const int* pexp;
    __device__ void init(int P0_, int P1_, int nN_, int G_, int c_, int up_, const int* pexp_) { P0 = P0_; nM = P1_ - P0_; if (nM < 0) nM = 0; nN = nN_; nwg = nM * nN; G = G_; c = c_; up = up_; pexp = pexp_; }
    __device__ bool next(int i, Unit& u) const {
        const long L = (long)i * G + c; if (L >= nwg) return false;
        int wgid = (int)L; { const int q = nwg / NXCD, r = nwg % NXCD, xcd = wgid % NXCD, off = wgid / NXCD; wgid = (xcd < r ? xcd * (q + 1) : r * (q + 1) + (xcd - r) * q) + off; }
        const int nig = WGM * nN, gid = wgid / nig, fm = gid * WGM, gsz = (nM - fm) < WGM ? (nM - fm) : WGM;
        const int pl = fm + ((wgid % nig) % gsz), pn = (wgid % nig) / gsz;
        const int e = __builtin_amdgcn_readfirstlane(pexp[P0 + pl]);
        u.pn = pn; u.pb = e * nN + pn;
        if (up) { u.pa = P0 + pl; u.pm = pl; } else { u.pa = pl; u.pm = P0 + pl; }
        return true;
    }
};

__device__ __forceinline__ h16x8 pack8(const f32x4 a, const f32x4 b) { h16x8 w; w[0] = (h16)a[0]; w[1] = (h16)a[1]; w[2] = (h16)a[2]; w[3] = (h16)a[3]; w[4] = (h16)b[0]; w[5] = (h16)b[1]; w[6] = (h16)b[2]; w[7] = (h16)b[3]; return w; }
__device__ __forceinline__ float silu_f(float x) { return x * __builtin_amdgcn_rcpf(1.0f + __expf(-x)); }
__device__ __forceinline__ float sigmoid_f(float x) { return __builtin_amdgcn_rcpf(1.0f + __expf(-x)); }

struct EpiStoreH {
    h16* O; int ldc;
    __device__ __forceinline__ void operator()(const f32x4 (&acc)[2][2][4][2], const Unit& u, int wr, int wc, int fr, int fq) const {
        const int row0 = u.pm * BM + wr * 64 + fr, col0 = u.pn * BM + wc * 32 + 8 * fq;
#pragma unroll
        for (int ai = 0; ai < 2; ++ai)
#pragma unroll
            for (int m = 0; m < 4; ++m) { h16* rowp = O + (size_t)(row0 + ai * HALF + m * 16) * ldc + col0;
#pragma unroll
                for (int bj = 0; bj < 2; ++bj) *(h16x8*)(rowp + bj * HALF) = pack8(acc[ai][bj][m][0], acc[ai][bj][m][1]); }
    }
};
struct EpiResid {
    h16* Y; const h16* R;
    __device__ __forceinline__ void operator()(const f32x4 (&acc)[2][2][4][2], const Unit& u, int wr, int wc, int fr, int fq) const {
        const int row0 = u.pm * BM + wr * 64 + fr, col0 = u.pn * BM + wc * 32 + 8 * fq;
#pragma unroll
        for (int ai = 0; ai < 2; ++ai)
#pragma unroll
            for (int m = 0; m < 4; ++m) { const size_t off = (size_t)(row0 + ai * HALF + m * 16) * DM + col0;
#pragma unroll
                for (int bj = 0; bj < 2; ++bj) { const h16x8 r = *(const h16x8*)(R + off + bj * HALF); const f32x4 a = acc[ai][bj][m][0], b = acc[ai][bj][m][1]; h16x8 w;
#pragma unroll
                    for (int j = 0; j < 4; ++j) { w[j] = (h16)(DN_ALPHA * (float)r[j] + a[j]); w[4 + j] = (h16)(DN_ALPHA * (float)r[4 + j] + b[j]); }
                    *(h16x8*)(Y + off + bj * HALF) = w; } }
    }
};
struct EpiSwiGLU {
    h16* Hd; int ldh;
    __device__ __forceinline__ void operator()(const f32x4 (&acc)[2][2][4][2], const Unit& u, int wr, int wc, int fr, int fq) const {
        const int row0 = u.pm * BM + wr * 64 + fr, col0 = u.pn * HALF + wc * 32 + 8 * fq;
#pragma unroll
        for (int ai = 0; ai < 2; ++ai)
#pragma unroll
            for (int m = 0; m < 4; ++m) { h16x8 w;
#pragma unroll
                for (int n = 0; n < 2; ++n)
#pragma unroll
                    for (int j = 0; j < 4; ++j) w[4 * n + j] = (h16)(silu_f(acc[ai][0][m][n][j]) * acc[ai][1][m][n][j]);
                *(h16x8*)(Hd + (size_t)(row0 + ai * HALF + m * 16) * ldh + col0) = w; }
    }
};
struct EpiPle {
    const h16* X; const h16* PP; h16* Oh; float* Of; int fin;
    __device__ __forceinline__ void operator()(const f32x4 (&acc)[2][2][4][2], const Unit& u, int wr, int wc, int fr, int fq) const {
        const int row0 = u.pm * BM + wr * 64 + fr, col0 = u.pn * BM + wc * 32 + 8 * fq;
#pragma unroll
        for (int ai = 0; ai < 2; ++ai)
#pragma unroll
            for (int m = 0; m < 4; ++m) { const size_t off = (size_t)(row0 + ai * HALF + m * 16) * DM + col0;
#pragma unroll
                for (int bj = 0; bj < 2; ++bj) { const h16x8 x = *(const h16x8*)(X + off + bj * HALF), p = *(const h16x8*)(PP + off + bj * HALF); const f32x4 a = acc[ai][bj][m][0], b = acc[ai][bj][m][1];
                    f32x4 o0, o1;
#pragma unroll
                    for (int j = 0; j < 4; ++j) { o0[j] = (float)x[j] + sigmoid_f(a[j]) * (float)p[j]; o1[j] = (float)x[4 + j] + sigmoid_f(b[j]) * (float)p[4 + j]; }
                    if (fin) { *(f32x4*)(Of + off + bj * HALF) = o0; *(f32x4*)(Of + off + bj * HALF + 4) = o1; }
                    else *(h16x8*)(Oh + off + bj * HALF) = pack8(o0, o1); } }
    }
};
struct EpiMoeDown {
    h16* ys; const int* rowslot; const int* meta;
    __device__ __forceinline__ void operator()(const f32x4 (&acc)[2][2][4][2], const Unit& u, int wr, int wc, int fr, int fq) const {
        const int row0 = u.pm * BM + wr * 64 + fr, col0 = u.pn * BM + wc * 32 + 8 * fq;
        const int e = u.pb >> 2;
        const int lim = meta[8 + e] + meta[e];
#pragma unroll
        for (int ai = 0; ai < 2; ++ai)
#pragma unroll
            for (int m = 0; m < 4; ++m) { const int r = row0 + ai * HALF + m * 16;
                if (r < lim) { const int slot = rowslot[r]; h16* rowp = ys + (size_t)slot * DM + col0;
#pragma unroll
                    for (int bj = 0; bj < 2; ++bj) *(h16x8*)(rowp + bj * HALF) = pack8(acc[ai][bj][m][0], acc[ai][bj][m][1]); } }
    }
};

template <class Epi, class Sched, bool ALIGN_EPI>
__device__ __forceinline__ void gemm_phase(LAS unsigned char* lds, const Gemm g, const Sched& S, const Epi& E) {
    int tid_ = threadIdx.x; asm volatile("" : "+v"(tid_));
    const int tid = tid_, wid = __builtin_amdgcn_readfirstlane(tid >> 6), lane = tid & 63, wr = wid >> 2, wc = wid & 3, fr = lane & 15, fq = lane >> 4;
    const int K = g.K, nt = K / BK;
    unsigned voffA[2], voffB[2];
#pragma unroll
    for (int i = 0; i < 2; ++i) { int R, C; stage_rc(tid * 16 + i * 8192, R, C); const int Rb = (R & ~31) + perm32(R & 31);
        voffA[i] = (unsigned)(R * K + C) * 2u; voffB[i] = (unsigned)(Rb * K + C) * 2u; }
    const size_t kstep = (size_t)(BK * 2);
    const size_t hstep = (size_t)HALF * K * 2;
    const size_t tstep = 2 * hstep;
    const unsigned ldsw = (unsigned)wid * 1024u;
    const int aoff = lds_byte(wr * 64 + fr, fq * 8), boff = lds_byte(wc * 32 + fr, fq * 8);
#define PG8_SA(b, h) (((b) * 2 + (h)) * HTB)
#define PG8_SB(b, h) ((4 + (b) * 2 + (h)) * HTB)
#define PG8_STAGE(bufoff, gbase, voff) do { _Pragma("unroll") for (int _i = 0; _i < 2; ++_i) \
        __builtin_amdgcn_global_load_lds((const unsigned*)((const char*)(gbase) + (voff)[_i]), (LAS unsigned*)(lds + (bufoff) + ldsw + _i * 8192), 16, 0, 0); } while (0)
#define PG8_LDA(dst, b, h) do { _Pragma("unroll") for (int m = 0; m < 4; ++m) _Pragma("unroll") for (int k = 0; k < 2; ++k) dst[m][k] = *(const LAS h16x8*)(lds + PG8_SA(b, h) + aoff + m * 2048 + k * 1024); } while (0)
#define PG8_LDB(dst, b, h) do { _Pragma("unroll") for (int n = 0; n < 2; ++n) _Pragma("unroll") for (int k = 0; k < 2; ++k) dst[n][k] = *(const LAS h16x8*)(lds + PG8_SB(b, h) + boff + n * 2048 + k * 1024); } while (0)
#define PG8_MMA(ai, bj, At, Bt) do { __builtin_amdgcn_s_setprio(1); _Pragma("unroll") for (int m = 0; m < 4; ++m) _Pragma("unroll") for (int n = 0; n < 2; ++n) _Pragma("unroll") for (int k = 0; k < 2; ++k) \
        acc[ai][bj][m][n] = __builtin_amdgcn_mfma_f32_16x16x32_f16(Bt[n][k], At[m][k], acc[ai][bj][m][n], 0, 0, 0); __builtin_amdgcn_s_setprio(0); } while (0)
#define PG8_WAIT_V(n) asm volatile("s_waitcnt vmcnt(" #n ")" ::: "memory")
#define PG8_WAIT_L(n) asm volatile("s_waitcnt lgkmcnt(" #n ")" ::: "memory")
#define PG8_BAR __builtin_amdgcn_s_barrier()
#define PG8_SCHED __builtin_amdgcn_sched_barrier(0)
    Unit cur, nxt; int ui = 0;
    if (!S.next(0, cur)) return;
    f32x4 acc[2][2][4][2];
#pragma unroll
    for (int a = 0; a < 2; ++a)
#pragma unroll
        for (int b = 0; b < 2; ++b)
#pragma unroll
            for (int m = 0; m < 4; ++m)
#pragma unroll
                for (int n = 0; n < 2; ++n) acc[a][b][m][n] = (f32x4){0.f, 0.f, 0.f, 0.f};
    h16x8 At[4][2], B0[2][2], B1[2][2];
    const char* cA = (const char*)g.A + (size_t)cur.pa * tstep; const char* cB = (const char*)g.Bt + (size_t)cur.pb * tstep;
    PG8_STAGE(PG8_SB(0, 0), cB, voffB); PG8_STAGE(PG8_SB(0, 1), cB + hstep, voffB); PG8_STAGE(PG8_SA(0, 0), cA, voffA); PG8_STAGE(PG8_SA(0, 1), cA + hstep, voffA);
    if (wr == 1) PG8_BAR;
    PG8_WAIT_V(2); PG8_BAR;
    PG8_STAGE(PG8_SB(1, 0), cB + kstep, voffB); PG8_STAGE(PG8_SA(1, 0), cA + kstep, voffA); PG8_STAGE(PG8_SB(1, 1), cB + hstep + kstep, voffB);
    PG8_WAIT_V(6); PG8_BAR;
    for (;;) {
        const bool has_next = S.next(ui + 1, nxt);
        const char* nA = has_next ? (const char*)g.A + (size_t)nxt.pa * tstep : cA; const char* nB = has_next ? (const char*)g.Bt + (size_t)nxt.pb * tstep : cB;
        for (int t = 0; t < nt; t += 2) {
            const bool last = (t == nt - 2);
            const char* a1 = cA + (size_t)(t + 1) * kstep;
            const char* a2 = last ? nA : cA + (size_t)(t + 2) * kstep; const char* b2 = last ? nB : cB + (size_t)(t + 2) * kstep;
            const char* a3 = a2 + kstep; const char* b3 = b2 + kstep;
            PG8_LDB(B0, 0, 0); PG8_LDB(B1, 0, 1); PG8_SCHED; PG8_LDA(At, 0, 0); PG8_STAGE(PG8_SA(1, 1), a1 + hstep, voffA);
            PG8_WAIT_V(8); PG8_WAIT_L(0); PG8_BAR; PG8_MMA(0, 0, At, B0); PG8_MMA(0, 1, At, B1); PG8_BAR; PG8_SCHED;
            PG8_LDA(At, 0, 1); PG8_STAGE(PG8_SB(0, 0), b2, voffB); PG8_STAGE(PG8_SB(0, 1), b2 + hstep, voffB); PG8_STAGE(PG8_SA(0, 0), a2, voffA);
            PG8_WAIT_V(8); PG8_WAIT_L(0); PG8_BAR; PG8_MMA(1, 0, At, B0); PG8_MMA(1, 1, At, B1); PG8_BAR; PG8_SCHED;
            PG8_LDB(B0, 1, 0); PG8_LDB(B1, 1, 1); PG8_SCHED; PG8_LDA(At, 1, 0); PG8_STAGE(PG8_SA(0, 1), a2 + hstep, voffA);
            PG8_WAIT_V(8); PG8_WAIT_L(0); PG8_BAR; PG8_MMA(0, 0, At, B0); PG8_MMA(0, 1, At, B1); PG8_BAR; PG8_SCHED;
            PG8_LDA(At, 1, 1); PG8_STAGE(PG8_SB(1, 0), b3, voffB); PG8_STAGE(PG8_SB(1, 1), b3 + hstep, voffB); PG8_STAGE(PG8_SA(1, 0), a3, voffA);
            PG8_WAIT_V(8); PG8_WAIT_L(0); PG8_BAR; PG8_MMA(1, 0, At, B0); PG8_MMA(1, 1, At, B1); PG8_BAR; PG8_SCHED;
        }
        if constexpr (ALIGN_EPI) { if (wr == 0) PG8_BAR; }
        E(acc, cur, wr, wc, fr, fq);
        if (!has_next) break;
#pragma unroll
        for (int a = 0; a < 2; ++a)
#pragma unroll
            for (int b = 0; b < 2; ++b)
#pragma unroll
                for (int m = 0; m < 4; ++m)
#pragma unroll
                    for (int n = 0; n < 2; ++n) acc[a][b][m][n] = (f32x4){0.f, 0.f, 0.f, 0.f};
        cur = nxt; cA = nA; cB = nB; ++ui;
        if constexpr (ALIGN_EPI) { if (wr == 1) PG8_BAR; }
    }
    PG8_WAIT_V(0);
    if constexpr (!ALIGN_EPI) { if (wr == 0) PG8_BAR; }
    PG8_BAR;
#undef PG8_SA
#undef PG8_SB
#undef PG8_STAGE
#undef PG8_LDA
#undef PG8_LDB
#undef PG8_MMA
#undef PG8_WAIT_V
#undef PG8_WAIT_L
#undef PG8_BAR
#undef PG8_SCHED
}
}

constexpr size_t MiB = 1u << 20;
constexpr size_t WS_CTL = 0, CTL_ZERO_BYTES = 1 * MiB;
constexpr size_t WS_KMEAN = 1 * MiB;
constexpr size_t WS_BIASL = 1 * MiB + 512 * 1024;
constexpr size_t WS_META = 1 * MiB + 768 * 1024;
constexpr size_t WS_ROUTE = 2 * MiB;
constexpr size_t WS_ROWSLOT = 3 * MiB;
constexpr size_t WS_ROPE = 4 * MiB;
constexpr size_t WS_WIN0 = 8 * MiB;
constexpr size_t WS_WOUT0 = 15 * MiB;
constexpr size_t WS_W13_0 = 17 * MiB;
constexpr size_t WS_W2_0 = 28 * MiB;
constexpr size_t WS_WG0 = 34 * MiB, WS_WG1 = 36 * MiB;
constexpr size_t WS_WP0 = 38 * MiB, WS_WP1 = 38 * MiB + 512 * 1024;
constexpr size_t WS_WIN1 = 39 * MiB;
constexpr size_t WS_WOUT1 = 45 * MiB;
constexpr size_t WS_PH = 48 * MiB;
constexpr size_t WS_XA = 80 * MiB, WS_XB = 144 * MiB;
constexpr size_t WS_R = 208 * MiB;
constexpr size_t WS_H = WS_R;
constexpr size_t WS_Y = WS_R;
constexpr size_t WS_MIXIN0 = WS_R + 208 * MiB;
constexpr size_t WS_U0 = WS_R + 272 * MiB, WS_ST0 = WS_R + 304 * MiB, WS_DV0 = WS_R + 336 * MiB;
constexpr size_t WS_LIST = WS_R + 340 * MiB;
constexpr size_t WS_HID = WS_R + 64 * MiB;
constexpr size_t WS_PP = WS_R + 244 * MiB;
constexpr size_t WS_MIXIN1 = WS_R + 192 * MiB;
constexpr size_t WS_U1 = WS_R + 256 * MiB, WS_ST1 = WS_R + 320 * MiB, WS_DV1 = WS_R + 384 * MiB;
constexpr size_t WS_E2 = WS_XB;
constexpr size_t WS_E13 = WS_R;
constexpr size_t WS_XS = WS_R + 112 * MiB;
constexpr size_t WS_HQ = WS_R + 244 * MiB;
constexpr size_t WS_END = 600 * MiB;
static_assert(WS_DV1 + 1 * MiB <= WS_END && WS_HQ + (size_t)MOE_PPP * 256 * FE * 2 <= WS_END && WS_LIST + 16 * MiB <= WS_END, "ws map");
static_assert(WS_HID + (size_t)M * FDP * 2 <= WS_PP && WS_XS + (size_t)MOE_PANELS * 256 * DM * 2 <= WS_HQ, "ws map 2");
constexpr size_t DO_PO = 0, DO_PML = 96 * MiB;

constexpr int CW_BAR = 4096;
constexpr int CW_MOBACNT = 16384;
constexpr int CW_MOECNT = 20480;

constexpr int RING_BYTES = 131072;
constexpr int LDSCTL_OFF = RING_BYTES;
constexpr int LDS_X_OFF = RING_BYTES + 256;
constexpr int LDS_BYTES = 163840;

#define XB_TMO      128
#define XB_XCNT(j)  (256  + 64 * (j))
#define XB_XSUB(j)  (1280 + 64 * (j))
#define XB_XGEN(j)  (2304 + 64 * (j))
#define XB_TOP      3328
#define XB_TOPGEN   3392
#define XCD_BAR_WORDS 3456
#define XB_SPIN_CAP (1u << 18)
__device__ __forceinline__ unsigned xb_ld(unsigned* p)              { return __hip_atomic_load(p, __ATOMIC_RELAXED, __HIP_MEMORY_SCOPE_AGENT); }
__device__ __forceinline__ unsigned xb_add(unsigned* p, unsigned v) { return __hip_atomic_fetch_add(p, v, __ATOMIC_RELAXED, __HIP_MEMORY_SCOPE_AGENT); }
__device__ __forceinline__ unsigned xb_xcc_id() { return (unsigned)__builtin_amdgcn_s_getreg((3 << 11) | 20) & 0xFu; }
#define XB_SPIN(cond, bar) do { unsigned _sp = 0; while (cond) { __builtin_amdgcn_s_sleep(1); \
    if ((++_sp & 255u) == 0u) { if (xb_ld(&(bar)[XB_TMO])) break; if (_sp > XB_SPIN_CAP) { atomicAdd(&(bar)[XB_TMO], 1u); break; } } } } while (0)
struct XcdBarrier { unsigned* bar; unsigned x; volatile LAS unsigned* st; };
__device__ __forceinline__ XcdBarrier xcd_barrier_post(unsigned* bar, volatile LAS unsigned* st) {
    XcdBarrier b; b.bar = bar; b.x = xb_xcc_id(); b.st = st;
    if (threadIdx.x == 0) (void)xb_add(&bar[XB_XCNT(b.x)], 1u);
    return b;
}
__device__ __forceinline__ void xcd_barrier_complete(unsigned* bar, unsigned x, unsigned& nloc, unsigned& nx) {
    const unsigned G = gridDim.x * gridDim.y * gridDim.z;
    unsigned sum, cnt, mine, sp = 0u;
    for (;;) {
        sum = 0u; cnt = 0u; mine = 0u;
#pragma unroll
        for (unsigned j = 0; j < 16; ++j) { const unsigned c = xb_ld(&bar[XB_XCNT(j)]); sum += c; cnt += (c > 0u) ? 1u : 0u; mine = (j == x) ? c : mine; }
        if (sum == G) break;
        __builtin_amdgcn_s_sleep(1);
        if ((++sp & 255u) == 0u) { if (xb_ld(&bar[XB_TMO])) break; if (sp > XB_SPIN_CAP) { atomicAdd(&bar[XB_TMO], 1u); break; } }
    }
    nloc = mine > 0u ? mine : 1u; nx = cnt > 0u ? cnt : 1u;
}
__device__ __forceinline__ void xcd_barrier(const XcdBarrier& b) {
    asm volatile("s_waitcnt vmcnt(0)" ::: "memory");
    __syncthreads();
    if (threadIdx.x == 0) {
        unsigned* bar = b.bar;
        __builtin_amdgcn_s_waitcnt(0);
        unsigned nloc = b.st[0], nx = b.st[1];
        if (nloc == 0u) { xcd_barrier_complete(bar, b.x, nloc, nx); b.st[0] = nloc; b.st[1] = nx; }
        const unsigned old = xb_add(&bar[XB_XSUB(b.x)], 1u);
        const unsigned gen = old / nloc;
        if (old + 1u == (gen + 1u) * nloc) {
            __builtin_amdgcn_fence(__ATOMIC_RELEASE, "agent");
            asm volatile("s_waitcnt vmcnt(0)" ::: "memory");
            const unsigned og = xb_add(&bar[XB_TOP], 1u);
            const unsigned tg = og / nx;
            if (og + 1u == (tg + 1u) * nx) xb_add(&bar[XB_TOPGEN], 1u);
            else XB_SPIN(xb_ld(&bar[XB_TOPGEN]) == tg, bar);
            __builtin_amdgcn_fence(__ATOMIC_ACQUIRE, "agent");
            xb_add(&bar[XB_XGEN(b.x)], 1u);
            asm volatile("s_waitcnt vmcnt(0)" ::: "memory");
        } else {
            XB_SPIN(xb_ld(&bar[XB_XGEN(b.x)]) == gen, bar);
            __builtin_amdgcn_fence(__ATOMIC_ACQUIRE, "agent");
            asm volatile("s_waitcnt vmcnt(0)" ::: "memory");
        }
    }
    __syncthreads();
}

struct Args { const float* in[27]; float* out; unsigned char* ws; int ph_lo, ph_hi; };
enum InIdx { I_X = 0, I_P, I_RELB, I_EWIN, I_GLAWG, I_GLABG, I_GLAN, I_EWOUT, I_OWIN, I_HGAMMA, I_HNORM, I_RNORM, I_OWOUT, I_LMG, I_LMB, I_LFG, I_LFB,
             I_FW1, I_FW3, I_FW2, I_RW, I_RB, I_XW1, I_XW3, I_XW2, I_PWG, I_PWP };
struct Frame {
    LAS unsigned char* lds; int tid, lane, wave, vcu, G; unsigned char* ws; gu32* ctl; const Args* a;
};
__device__ __forceinline__ void launder(Frame& F) {
    int t = threadIdx.x; asm volatile("" : "+v"(t)); F.tid = t; F.lane = t & 63; F.wave = __builtin_amdgcn_readfirstlane(t >> 6);
    unsigned char* w = F.ws; asm volatile("" : "+s"(w)); F.ws = w; F.ctl = (gu32*)(w + WS_CTL);
}
__device__ __forceinline__ float wave_sum(float v) {
#pragma unroll
    for (int o = 1; o < 64; o <<= 1) v += __shfl_xor(v, o);
    return v;
}

__device__ __forceinline__ int rowmap(int mode, int n) {
    if (mode == 0) return n;
    if (mode == 1) return n < 2560 ? n : (n < 2576 ? 3072 + (n - 2560) : 2560 + (n - 2576));
    if (mode == 2) return (n >> 7) * 256 + (n & 127);
    return (n >> 7) * 256 + 128 + (n & 127);
}
__device__ __forceinline__ void transpose_item(const float* W, int N, h16* WT, int ldk, int mode, LAS float* scr, int item, int lane) {
    const int nblk = (N + 31) / 32, kb = item / nblk, nb = item % nblk, k0 = 64 * kb, n0 = 32 * nb;
    const int nn = n0 + (lane & 31); const bool ok = nn < N;
#pragma unroll 8
    for (int i = 0; i < 32; ++i) { const int kk = 2 * i + (lane >> 5); scr[kk * 33 + (lane & 31)] = ok ? W[(size_t)(k0 + kk) * N + nn] : 0.f; }
    LDS_WAIT(); asm volatile("" ::: "memory");
    const int c = lane & 7;
#pragma unroll
    for (int j = 0; j < 4; ++j) { const int n = (lane >> 3) + 8 * j; const LAS float* s = scr + (8 * c) * 33 + n;
        if (n0 + n < N) { h16x8 o;
#pragma unroll
            for (int q = 0; q < 8; ++q) o[q] = (h16)s[q * 33];
            *(h16x8*)(WT + (size_t)rowmap(mode, n0 + n) * ldk + k0 + 8 * c) = o; } }
    LDS_WAIT(); asm volatile("" ::: "memory");
}
struct TDesc { const float* W; int K, N; h16* WT; int ldk, mode; };
__device__ __forceinline__ int titems(const TDesc& d) { return (d.K / 64) * ((d.N + 31) / 32); }

__device__ __forceinline__ void zero16(void* p) { *(u32x4*)p = (u32x4){0u, 0u, 0u, 0u}; }
__device__ __forceinline__ void cvt8(const float* src, h16* dst) { const f32x4 a = *(const f32x4*)src, b = *(const f32x4*)(src + 4); *(h16x8*)dst = pg8::pack8(a, b); }
__device__ __forceinline__ int t5_bucket(int n) {
    if (n < 16) return n < 0 ? 0 : n;
    int b = 16;
    b += (n >= 19) + (n >= 21) + (n >= 24) + (n >= 27) + (n >= 31) + (n >= 35) + (n >= 40) + (n >= 46) + (n >= 52) + (n >= 59) + (n >= 67) + (n >= 77) + (n >= 87) + (n >= 99) + (n >= 113);
    return b;
}
__device__ __forceinline__ void p_prologue(Frame& F) {
    const Args& A = *F.a; unsigned char* ws = F.ws;
    LAS float* scr = (LAS float*)(F.lds + F.wave * 16384);
    const int gw = F.vcu * NWAVES + F.wave, NGW = F.G * NWAVES;
    constexpr int T0 = 16 * 97, T1 = 16 * 32, T2 = 16 * 86, T3 = T2, T4 = 43 * 32, T5 = 16 * 32, T6 = T5, T7 = 4 * 32, T8 = T7, T9 = 16 * 96, T10 = 16 * 32;
    constexpr int NT = T0 + T1 + T2 + T3 + T4 + T5 + T6 + T7 + T8 + T9 + T10;
    for (int it = gw; it < NT; it += NGW) {
        int r = it;
        if (r < T0) { transpose_item(A.in[I_EWIN], 3088, (h16*)(ws + WS_WIN0), 1024, 1, scr, r, F.lane); continue; } r -= T0;
        if (r < T1) { transpose_item(A.in[I_EWOUT], 1024, (h16*)(ws + WS_WOUT0), 1024, 0, scr, r, F.lane); continue; } r -= T1;
        if (r < T2) { transpose_item(A.in[I_FW1], FD, (h16*)(ws + WS_W13_0), 1024, 2, scr, r, F.lane); continue; } r -= T2;
        if (r < T3) { transpose_item(A.in[I_FW3], FD, (h16*)(ws + WS_W13_0), 1024, 3, scr, r, F.lane); continue; } r -= T3;
        if (r < T4) { transpose_item(A.in[I_FW2], 1024, (h16*)(ws + WS_W2_0), FDP, 0, scr, r, F.lane); continue; } r -= T4;
        if (r < T5) { transpose_item(A.in[I_PWG], 1024, (h16*)(ws + WS_WG0), 1024, 0, scr, r, F.lane); continue; } r -= T5;
        if (r < T6) { transpose_item(A.in[I_PWG] + 1024 * 1024, 1024, (h16*)(ws + WS_WG1), 1024, 0, scr, r, F.lane); continue; } r -= T6;
        if (r < T7) { transpose_item(A.in[I_PWP], 1024, (h16*)(ws + WS_WP0), 256, 0, scr, r, F.lane); continue; } r -= T7;
        if (r < T8) { transpose_item(A.in[I_PWP] + 256 * 1024, 1024, (h16*)(ws + WS_WP1), 256, 0, scr, r, F.lane); continue; } r -= T8;
        if (r < T9) { transpose_item(A.in[I_OWIN], N1, (h16*)(ws + WS_WIN1), 1024, 0, scr, r, F.lane); continue; } r -= T9;
        transpose_item(A.in[I_OWOUT], 1024, (h16*)(ws + WS_WOUT1), 1024, 0, scr, r, F.lane);
    }
    const size_t gt = (size_t)F.vcu * NTHR + F.tid, NGT = (size_t)F.G * NTHR;
    { h16* w = (h16*)(ws + WS_WIN0) + (size_t)3088 * 1024; for (size_t i = gt; i < 30720; i += NGT) zero16(w + i * 8); }
    { h16* w = (h16*)(ws + WS_W13_0); for (size_t i = gt; i < 128 * 128; i += NGT) { const int rr = (int)(i >> 7), ch = (int)(i & 127); const int row = 21 * 256 + (rr < 64 ? 64 + rr : 128 + 64 + (rr - 64)); zero16(w + (size_t)row * 1024 + ch * 8); } }
    { h16* w = (h16*)(ws + WS_W2_0); for (size_t i = gt; i < 1024 * 8; i += NGT) { const int row = (int)(i >> 3), ch = (int)(i & 7); zero16(w + (size_t)row * FDP + FD + ch * 8); } }
    { const float* x = A.in[I_X]; h16* xa = (h16*)(ws + WS_XA); for (size_t i = gt; i < (size_t)M * DM / 8; i += NGT) cvt8(x + i * 8, xa + i * 8); }
    { const float* p = A.in[I_P]; h16* ph = (h16*)(ws + WS_PH); for (size_t i = gt; i < (size_t)2 * M * PLE / 8; i += NGT) cvt8(p + i * 8, ph + i * 8); }
    { float* rc = (float*)(ws + WS_ROPE); float* rs = rc + SEQ * 32;
      for (size_t i = gt; i < (size_t)SEQ * 32; i += NGT) { const int t = (int)(i >> 5), k = (int)(i & 31); const float inv = (float)pow(10000.0, -(double)k / 32.0); const float ang = (float)t * inv;
          rc[i] = (float)cos((double)ang); rs[i] = (float)sin((double)ang); } }
    { float* bl = (float*)(ws + WS_BIASL); const float* rb = A.in[I_RELB]; for (size_t i = gt; i < 8 * 128; i += NGT) { const int h = (int)(i >> 7), d = (int)(i & 127); bl[i] = rb[t5_bucket(d) * 8 + h]; } }
}

template <int MODE>
__device__ __forceinline__ void ln_phase(Frame& F, const h16* Y, const float* gam, const float* bet, h16* Xout, const h16* XR, const h16* ys) {
    const Args& A = *F.a;
    LAS float* wr_l = (LAS float*)F.lds;
    LAS int* rt_l = (LAS int*)(F.lds + 32768);
    LAS float* rg_l = (LAS float*)(F.lds + 32768 + 2048);
    LAS int* lcnt = (LAS int*)(F.lds + 32768 + 4096);
    int* route = (int*)(F.ws + WS_ROUTE);
    if (MODE == 1) { const float* rw = A.in[I_RW]; for (int i = F.tid; i < 8192; i += NTHR) wr_l[i] = rw[i]; }
    f32x4 g4[4], b4[4];
#pragma unroll
    for (int j = 0; j < 2; ++j) { const int c = j * 512 + F.lane * 8; g4[2 * j] = *(const f32x4*)(gam + c); g4[2 * j + 1] = *(const f32x4*)(gam + c + 4); b4[2 * j] = *(const f32x4*)(bet + c); b4[2 * j + 1] = *(const f32x4*)(bet + c + 4); }
    for (int rb = F.vcu * 128; rb < M; rb += F.G * 128) {
        if (MODE == 1) { if (F.tid < 16) lcnt[F.tid] = 0; __syncthreads(); }
        for (int i = 0; i < 16; ++i) {
            const int row = rb + F.wave * 16 + i;
            float v[16];
            if (MODE == 2) {
                const int* rr = route + (size_t)row * 8; const float g0 = __int_as_float(rr[4]), g1 = __int_as_float(rr[5]);
#pragma unroll
                for (int j = 0; j < 2; ++j) { const int c = j * 512 + F.lane * 8; const h16x8 xr = *(const h16x8*)(XR + (size_t)row * DM + c), y0 = *(const h16x8*)(ys + (size_t)(2 * row) * DM + c), y1 = *(const h16x8*)(ys + (size_t)(2 * row + 1) * DM + c);
#pragma unroll
                    for (int q = 0; q < 8; ++q) v[8 * j + q] = DN_ALPHA * (float)xr[q] + g0 * (float)y0[q] + g1 * (float)y1[q]; }
            } else {
#pragma unroll
                for (int j = 0; j < 2; ++j) { const h16x8 y = *(const h16x8*)(Y + (size_t)row * DM + j * 512 + F.lane * 8);
#pragma unroll
                    for (int q = 0; q < 8; ++q) v[8 * j + q] = (float)y[q]; }
            }
            float s = 0.f;
#pragma unroll
            for (int q = 0; q < 16; ++q) s += v[q];
            const float mean = wave_sum(s) * (1.f / DM); float s2 = 0.f;
#pragma unroll
            for (int q = 0; q < 16; ++q) { v[q] -= mean; s2 += v[q] * v[q]; }
            const float rstd = 1.f / sqrtf(wave_sum(s2) * (1.f / DM) + LN_EPS);
#pragma unroll
            for (int q = 0; q < 16; ++q) v[q] = v[q] * rstd * g4[q >> 2][q & 3] + b4[q >> 2][q & 3];
#pragma unroll
            for (int j = 0; j < 2; ++j) { h16x8 o;
#pragma unroll
                for (int q = 0; q < 8; ++q) o[q] = (h16)v[8 * j + q];
                *(h16x8*)(Xout + (size_t)row * DM + j * 512 + F.lane * 8) = o; }
            if (MODE == 1) {
                float lg[8];
#pragma unroll
                for (int e = 0; e < 8; ++e) lg[e] = 0.f;
#pragma unroll
                for (int j = 0; j < 2; ++j)
#pragma unroll
                    for (int q = 0; q < 8; ++q) { const int c = j * 512 + F.lane * 8 + q; const f32x4 w0 = *(const LAS f32x4*)(wr_l + c * 8), w1 = *(const LAS f32x4*)(wr_l + c * 8 + 4); const float x = v[8 * j + q];
                        lg[0] += x * w0[0]; lg[1] += x * w0[1]; lg[2] += x * w0[2]; lg[3] += x * w0[3]; lg[4] += x * w1[0]; lg[5] += x * w1[1]; lg[6] += x * w1[2]; lg[7] += x * w1[3]; }
#pragma unroll
                for (int e = 0; e < 8; ++e) lg[e] = wave_sum(lg[e]) + A.in[I_RB][e];
                if (F.lane == 0) {
                    int e0 = 0; float m0 = lg[0];
#pragma unroll
                    for (int e = 1; e < 8; ++e) if (lg[e] > m0) { m0 = lg[e]; e0 = e; }
                    int e1 = -1; float m1 = -INFINITY;
#pragma unroll
                    for (int e = 0; e < 8; ++e) if (e != e0 && lg[e] > m1) { m1 = lg[e]; e1 = e; }
                    const float g0 = 1.f / (1.f + expf(m1 - m0));
                    const int s0 = atomicAdd((int*)&lcnt[e0], 1), s1 = atomicAdd((int*)&lcnt[e1], 1);
                    const int li = F.wave * 16 + i;
                    rt_l[li * 4 + 0] = e0; rt_l[li * 4 + 1] = s0; rt_l[li * 4 + 2] = e1; rt_l[li * 4 + 3] = s1; rg_l[li * 2] = g0; rg_l[li * 2 + 1] = 1.f - g0;
                }
            }
        }
        if (MODE == 1) {
            __syncthreads();
            if (F.tid < 8) lcnt[8 + F.tid] = (int)__hip_atomic_fetch_add(F.ctl + CW_MOECNT + F.tid, (unsigned)lcnt[F.tid], RLX_AGENT);
            __syncthreads();
            if (F.tid < 128) { const int row = rb + F.tid; int* rr = route + (size_t)row * 8; const int e0 = rt_l[F.tid * 4], e1 = rt_l[F.tid * 4 + 2];
                rr[0] = e0; rr[1] = lcnt[8 + e0] + rt_l[F.tid * 4 + 1]; rr[2] = e1; rr[3] = lcnt[8 + e1] + rt_l[F.tid * 4 + 3]; rr[4] = __float_as_int(rg_l[F.tid * 2]); rr[5] = __float_as_int(rg_l[F.tid * 2 + 1]); }
            __syncthreads();
        }
    }
}

constexpr int KL_STRIDE = 72, VT_STRIDE = 264;
constexpr int LIST_PER_BH = 516096;
__device__ __forceinline__ int moba_binoff(int j) { return 256 * (63 * j - (j * (j - 1)) / 2); }

__device__ __forceinline__ void moba_kmean_unit(Frame& F, int u) {
    const int b = u >> 6, blk = u & 63; const h16* Hh = (const h16*)(F.ws + WS_H);
    const h16* p = Hh + (size_t)(b * SEQ + blk * 256) * N0 + C0_MK + F.tid;
    float s = 0.f;
#pragma unroll 8
    for (int r = 0; r < 256; ++r) s += (float)p[(size_t)r * N0];
    float* km = (float*)(F.ws + WS_KMEAN);
    km[((size_t)(b * 8 + (F.tid >> 6)) * 64 + blk) * 64 + (F.tid & 63)] = s * (1.f / 256.f);
}

__device__ __forceinline__ bool better(float av, int ai, float bv, int bi) { return av > bv || (av == bv && ai < bi); }
__device__ __forceinline__ void top3_insert(float g, int n, float& v0, int& i0, float& v1, int& i1, float& v2, int& i2) {
    const bool b2 = better(g, n, v2, i2), b1 = better(g, n, v1, i1), b0 = better(g, n, v0, i0);
    const float nv2 = b1 ? v1 : (b2 ? g : v2); const int ni2 = b1 ? i1 : (b2 ? n : i2);
    const float nv1 = b0 ? v0 : (b1 ? g : v1); const int ni1 = b0 ? i0 : (b1 ? n : i1);
    const float nv0 = b0 ? g : v0; const int ni0 = b0 ? n : i0;
    v0 = nv0; i0 = ni0; v1 = nv1; i1 = ni1; v2 = nv2; i2 = ni2;
}
__device__ __forceinline__ void moba_select_unit(Frame& F, int u) {
    const int bh = u / 63, c = 1 + u % 63, b = bh >> 3, h = bh & 7;
    LAS float* km = (LAS float*)F.lds; LAS int* hist = (LAS int*)(F.lds + 16384); LAS int* gbase = hist + 64;
    const float* kmg = (const float*)(F.ws + WS_KMEAN) + (size_t)bh * 64 * 64;
    __syncthreads();
    for (int i = F.tid; i < c * 64; i += NTHR) km[i] = kmg[i];
    if (F.tid < 64) hist[F.tid] = 0;
    const int q = F.tid >> 1, half = F.tid & 1;
    const h16* Hh = (const h16*)(F.ws + WS_H);
    const h16* qp = Hh + (size_t)(b * SEQ + c * 256 + q) * N0 + C0_MQ + h * 64;
    float qv[64];
#pragma unroll
    for (int j = 0; j < 8; ++j) { const h16x8 t = *(const h16x8*)(qp + 8 * j);
#pragma unroll
        for (int k = 0; k < 8; ++k) qv[8 * j + k] = (float)t[k]; }
    __syncthreads();
    float v0 = -INFINITY, v1 = -INFINITY, v2 = -INFINITY; int i0 = 1000, i1 = 1001, i2 = 1002;
    for (int n = half; n < c; n += 2) {
        const LAS f32x4* kr = (const LAS f32x4*)(km + n * 64); float g = 0.f;
#pragma unroll
        for (int j = 0; j < 16; ++j) { const f32x4 kk = kr[j]; g += qv[4 * j] * kk[0] + qv[4 * j + 1] * kk[1] + qv[4 * j + 2] * kk[2] + qv[4 * j + 3] * kk[3]; }
        top3_insert(g, n, v0, i0, v1, i1, v2, i2);
    }
    { const float pv0 = __shfl_xor(v0, 1), pv1 = __shfl_xor(v1, 1), pv2 = __shfl_xor(v2, 1); const int pi0 = __shfl_xor(i0, 1), pi1 = __shfl_xor(i1, 1), pi2 = __shfl_xor(i2, 1);
      top3_insert(pv0, pi0, v0, i0, v1, i1, v2, i2); top3_insert(pv1, pi1, v0, i0, v1, i1, v2, i2); top3_insert(pv2, pi2, v0, i0, v1, i1, v2, i2); }
    const int nvalid = c < 3 ? c : 3;
    int pos0 = 0, pos1 = 0, pos2 = 0;
    if (half == 0) { pos0 = atomicAdd((int*)&hist[i0], 1); if (nvalid > 1) pos1 = atomicAdd((int*)&hist[i1], 1); if (nvalid > 2) pos2 = atomicAdd((int*)&hist[i2], 1); }
    __syncthreads();
    if (F.tid < c) { const int n = hist[F.tid]; gbase[F.tid] = n ? (int)__hip_atomic_fetch_add(F.ctl + CW_MOBACNT + bh * 64 + F.tid, (unsigned)n, RLX_AGENT) : 0; }
    __syncthreads();
    if (half == 0) {
        unsigned short* list = (unsigned short*)(F.ws + WS_LIST) + (size_t)bh * LIST_PER_BH; const int t = c * 256 + q;
        list[moba_binoff(i0) + gbase[i0] + pos0] = (unsigned short)(t | (0 << 14));
        if (nvalid > 1) list[moba_binoff(i1) + gbase[i1] + pos1] = (unsigned short)(t | (1 << 14));
        if (nvalid > 2) list[moba_binoff(i2) + gbase[i2] + pos2] = (unsigned short)(t | (2 << 14));
    }
}

__device__ __forceinline__ void moba_stage(Frame& F, int b, int h, int j, LAS h16* K_l, LAS h16* VT_l, LAS float* BL_l) {
    const h16* Hh = (const h16*)(F.ws + WS_H);
    const h16* kb = Hh + (size_t)(b * SEQ + j * 256) * N0 + C0_MK + h * 64;
    const h16* vb = Hh + (size_t)(b * SEQ + j * 256) * N0 + C0_MV + h * 64;
#pragma unroll
    for (int i = 0; i < 4; ++i) { const int id = F.tid + i * NTHR, r = id >> 3, ch = id & 7;
        const h16x8 kv = *(const h16x8*)(kb + (size_t)r * N0 + ch * 8); *(LAS h16x8*)(K_l + r * KL_STRIDE + ch * 8) = kv;
        const h16x8 vv = *(const h16x8*)(vb + (size_t)r * N0 + ch * 8);
#pragma unroll
        for (int k = 0; k < 8; ++k) VT_l[(ch * 8 + k) * VT_STRIDE + r] = vv[k]; }
    if (F.tid < 128) BL_l[F.tid] = ((const float*)(F.ws + WS_BIASL))[h * 128 + F.tid];
}

__device__ __forceinline__ void block_scan_1024(Frame& F, int a, int b, LAS int* out, LAS int* wsum) {
    int s = a + b, inc = s;
#pragma unroll
    for (int o = 1; o < 64; o <<= 1) { const int t = __shfl_up(inc, o); if (F.lane >= o) inc += t; }
    if (F.lane == 63) wsum[F.wave] = inc;
    __syncthreads();
    int base = 0;
    for (int w = 0; w < F.wave; ++w) base += wsum[w];
    const int ex = base + inc - s;
    out[2 * F.tid] = ex; out[2 * F.tid + 1] = ex + a;
    if (F.tid == NTHR - 1) out[1024] = ex + s;
    __syncthreads();
}

__device__ __forceinline__ void moba_sparse_phase(Frame& F) {
    LAS h16* K_l = (LAS h16*)F.lds; LAS h16* VT_l = (LAS h16*)(F.lds + 36864); LAS float* BL_l = (LAS float*)(F.lds + 70656);
    LAS int* pfx = (LAS int*)(F.lds + 71680); LAS int* wsum = (LAS int*)(F.lds + 71680 + 4224);
    const gu32* cnts = F.ctl + CW_MOBACNT;
    int pa, pb; { const int b0 = 2 * F.tid, b1 = b0 + 1;
        pa = b0 < 1008 ? (int)((__hip_atomic_load(cnts + (b0 / 63) * 64 + b0 % 63, RLX_AGENT) + 511u) >> 9) : 0;
        pb = b1 < 1008 ? (int)((__hip_atomic_load(cnts + (b1 / 63) * 64 + b1 % 63, RLX_AGENT) + 511u) >> 9) : 0; }
    __syncthreads();
    block_scan_1024(F, pa, pb, pfx, wsum);
    const int NI = pfx[1008];
    const int k0 = (int)((long)F.vcu * NI / F.G), k1 = (int)((long)(F.vcu + 1) * NI / F.G);
    const h16* Hh = (const h16*)(F.ws + WS_H);
    h16* PO = (h16*)((unsigned char*)F.a->out + DO_PO); float* PML = (float*)((unsigned char*)F.a->out + DO_PML);
    int pbin = -1;
    const int q = F.lane & 15, fq = F.lane >> 4;
    for (int k = k0; k < k1; ++k) {
        int lo = 0, hi = 1007;
        while (lo < hi) { const int mid = (lo + hi + 1) >> 1; if (pfx[mid] <= k) lo = mid; else hi = mid - 1; }
        const int bin = lo, part = k - pfx[bin], bh = bin / 63, j = bin % 63, b = bh >> 3, h = bh & 7;
        if (bin != pbin) { __syncthreads(); moba_stage(F, b, h, j, K_l, VT_l, BL_l); pbin = bin; __syncthreads(); }
        const int cnt = (int)__hip_atomic_load(cnts + bh * 64 + j, RLX_AGENT);
        const unsigned short* list = (const unsigned short*)(F.ws + WS_LIST) + (size_t)bh * LIST_PER_BH + moba_binoff(j);
        const int nq = (cnt - part * 512) < 512 ? (cnt - part * 512) : 512, ntile = (nq + 15) >> 4;
        for (int tile = F.wave; tile < ntile; tile += NWAVES) {
            const int idx = part * 512 + tile * 16 + q; const bool valid = idx < cnt;
            const int entry = valid ? (int)list[idx] : ((j + 1) * 256);
            const int tq = entry & 0x3fff;
            const h16* qp = Hh + (size_t)(b * SEQ + tq) * N0 + C0_MQ + h * 64 + 8 * fq;
            const h16x8 qf0 = *(const h16x8*)qp, qf1 = *(const h16x8*)(qp + 32);
            f32x4 s[16];
#pragma unroll
            for (int kt = 0; kt < 16; ++kt) { const LAS h16* kp = K_l + (16 * kt + q) * KL_STRIDE + 8 * fq;
                f32x4 a = (f32x4){0.f, 0.f, 0.f, 0.f};
                a = __builtin_amdgcn_mfma_f32_16x16x32_f16(*(const LAS h16x8*)kp, qf0, a, 0, 0, 0);
                a = __builtin_amdgcn_mfma_f32_16x16x32_f16(*(const LAS h16x8*)(kp + 32), qf1, a, 0, 0, 0); s[kt] = a;
                if ((kt & 3) == 3) __builtin_amdgcn_sched_barrier(0); }
            const int dmin = tq - (256 * j + 255);
            float mx = -INFINITY;
            if (__all(dmin >= 113)) { const float bc = BL_l[127];
#pragma unroll
                for (int kt = 0; kt < 16; ++kt)
#pragma unroll
                    for (int r = 0; r < 4; ++r) { s[kt][r] = s[kt][r] * 0.125f + bc; mx = fmaxf(mx, s[kt][r]); }
            } else {
#pragma unroll
                for (int kt = 0; kt < 16; ++kt)
#pragma unroll
                    for (int r = 0; r < 4; ++r) { int d = tq - (256 * j + 16 * kt + 4 * fq + r); d = d > 127 ? 127 : (d < 0 ? 0 : d); s[kt][r] = s[kt][r] * 0.125f + BL_l[d]; mx = fmaxf(mx, s[kt][r]); }
            }
            mx = fmaxf(mx, __shfl_xor(mx, 16)); mx = fmaxf(mx, __shfl_xor(mx, 32));
            float l = 0.f; h16x8 pf[8];
#pragma unroll
            for (int ks = 0; ks < 8; ++ks) {
#pragma unroll
                for (int r = 0; r < 4; ++r) { const float p0 = __expf(s[2 * ks][r] - mx), p1 = __expf(s[2 * ks + 1][r] - mx); l += p0 + p1; pf[ks][r] = (h16)p0; pf[ks][4 + r] = (h16)p1; } }
            l += __shfl_xor(l, 16); l += __shfl_xor(l, 32);
            f32x4 o[4];
#pragma unroll
            for (int dt = 0; dt < 4; ++dt) { o[dt] = (f32x4){0.f, 0.f, 0.f, 0.f}; const LAS h16* vp = VT_l + (16 * dt + q) * VT_STRIDE + 4 * fq;
#pragma unroll
                for (int ks = 0; ks < 8; ++ks) { const h16x4 lo4 = *(const LAS h16x4*)(vp + 32 * ks), hi4 = *(const LAS h16x4*)(vp + 32 * ks + 16);
                    h16x8 vf; vf[0] = lo4[0]; vf[1] = lo4[1]; vf[2] = lo4[2]; vf[3] = lo4[3]; vf[4] = hi4[0]; vf[5] = hi4[1]; vf[6] = hi4[2]; vf[7] = hi4[3];
                    o[dt] = __builtin_amdgcn_mfma_f32_16x16x32_f16(pf[ks], vf, o[dt], 0, 0, 0); } }
            const int ev = valid ? entry : -1;
#pragma unroll
            for (int r = 0; r < 4; ++r) { const int e2 = __shfl(ev, 4 * fq + r);
                if (e2 >= 0) { const size_t base = (((size_t)(b * SEQ + (e2 & 0x3fff)) * 8 + h) * 3 + (e2 >> 14)) * 64 + q;
#pragma unroll
                    for (int dt = 0; dt < 4; ++dt) PO[base + 16 * dt] = (h16)o[dt][r]; } }
            if (fq == 0 && valid) { const size_t mi = (((size_t)(b * SEQ + tq) * 8 + h) * 3 + (entry >> 14)) * 2; *(f32x2*)(PML + mi) = (f32x2){mx, l}; }
        }
    }
}

__device__ __forceinline__ void moba_own_unit(Frame& F, int u) {
    const int bh = u >> 6, c = u & 63, b = bh >> 3, h = bh & 7;
    LAS h16* K_l = (LAS h16*)F.lds; LAS h16* VT_l = (LAS h16*)(F.lds + 36864); LAS float* BL_l = (LAS float*)(F.lds + 70656);
    __syncthreads(); moba_stage(F, b, h, c, K_l, VT_l, BL_l); __syncthreads();
    const h16* Hh = (const h16*)(F.ws + WS_H);
    const h16* PO = (const h16*)((unsigned char*)F.a->out + DO_PO); const float* PML = (const float*)((unsigned char*)F.a->out + DO_PML);
    h16* MX = (h16*)(F.ws + WS_MIXIN0);
    const int q = F.lane & 15, fq = F.lane >> 4; const int nvalid = c < 3 ? c : 3;
    for (int s2 = 0; s2 < 2; ++s2) {
        const int ti = s2 == 0 ? F.wave : 15 - F.wave;
        const int tl = 16 * ti + q; const size_t row = (size_t)b * SEQ + c * 256 + tl;
        const h16* qp = Hh + row * N0 + C0_MQ + h * 64 + 8 * fq;
        const h16x8 qf0 = *(const h16x8*)qp, qf1 = *(const h16x8*)(qp + 32);
        f32x4 s[16]; float mx = -INFINITY;
#pragma unroll
        for (int kt = 0; kt < 16; ++kt) {
            if (kt <= ti) { const LAS h16* kp = K_l + (16 * kt + q) * KL_STRIDE + 8 * fq;
                f32x4 a = (f32x4){0.f, 0.f, 0.f, 0.f};
                a = __builtin_amdgcn_mfma_f32_16x16x32_f16(*(const LAS h16x8*)kp, qf0, a, 0, 0, 0);
                a = __builtin_amdgcn_mfma_f32_16x16x32_f16(*(const LAS h16x8*)(kp + 32), qf1, a, 0, 0, 0);
#pragma unroll
                for (int r = 0; r < 4; ++r) { const int d = tl - (16 * kt + 4 * fq + r); const float v = a[r] * 0.125f + BL_l[d > 127 ? 127 : (d < 0 ? 0 : d)]; a[r] = d >= 0 ? v : -INFINITY; mx = fmaxf(mx, a[r]); }
                s[kt] = a;
            } else s[kt] = (f32x4){-INFINITY, -INFINITY, -INFINITY, -INFINITY};
        }
        mx = fmaxf(mx, __shfl_xor(mx, 16)); mx = fmaxf(mx, __shfl_xor(mx, 32));
        float l = 0.f; h16x8 pf[8];
#pragma unroll
        for (int ks = 0; ks < 8; ++ks) {
#pragma unroll
            for (int r = 0; r < 4; ++r) { const float p0 = __expf(s[2 * ks][r] - mx), p1 = __expf(s[2 * ks + 1][r] - mx); l += p0 + p1; pf[ks][r] = (h16)p0; pf[ks][4 + r] = (h16)p1; } }
        l += __shfl_xor(l, 16); l += __shfl_xor(l, 32);
        f32x4 o[4];
#pragma unroll
        for (int dt = 0; dt < 4; ++dt) { o[dt] = (f32x4){0.f, 0.f, 0.f, 0.f}; const LAS h16* vp = VT_l + (16 * dt + q) * VT_STRIDE + 4 * fq;
#pragma unroll
            for (int ks = 0; ks < 8; ++ks) { if (2 * ks <= ti) { const h16x4 lo4 = *(const LAS h16x4*)(vp + 32 * ks), hi4 = *(const LAS h16x4*)(vp + 32 * ks + 16);
                h16x8 vf; vf[0] = lo4[0]; vf[1] = lo4[1]; vf[2] = lo4[2]; vf[3] = lo4[3]; vf[4] = hi4[0]; vf[5] = hi4[1]; vf[6] = hi4[2]; vf[7] = hi4[3];
                o[dt] = __builtin_amdgcn_mfma_f32_16x16x32_f16(pf[ks], vf, o[dt], 0, 0, 0); } } }
        float mr[3], lr[3]; float Mx = mx;
#pragma unroll
        for (int k = 0; k < 3; ++k) { if (k < nvalid) { const f32x2 t = *(const f32x2*)(PML + ((row * 8 + h) * 3 + k) * 2); mr[k] = t[0]; lr[k] = t[1]; Mx = fmaxf(Mx, mr[k]); } else { mr[k] = -INFINITY; lr[k] = 0.f; } }
        const float wo = __expf(mx - Mx); float den = l * wo; float wk[3];
#pragma unroll
        for (int k = 0; k < 3; ++k) { wk[k] = k < nvalid ? __expf(mr[k] - Mx) : 0.f; den += lr[k] * wk[k]; }
        const float inv = 1.f / den;
#pragma unroll
        for (int r = 0; r < 4; ++r) { const int q2 = 4 * fq + r; const float wo2 = __shfl(wo, q2) , inv2 = __shfl(inv, q2); const float w0 = __shfl(wk[0], q2), w1 = __shfl(wk[1], q2), w2 = __shfl(wk[2], q2);
            const size_t row2 = (size_t)b * SEQ + c * 256 + 16 * ti + q2; const h16* pp = PO + ((row2 * 8 + h) * 3) * 64 + q;
#pragma unroll
            for (int dt = 0; dt < 4; ++dt) { float v = o[dt][r] * wo2;
                if (nvalid > 0) v += (float)pp[16 * dt] * w0;
                if (nvalid > 1) v += (float)pp[64 + 16 * dt] * w1;
                if (nvalid > 2) v += (float)pp[128 + 16 * dt] * w2;
                MX[row2 * DM + h * 64 + 16 * dt + q] = (h16)(v * inv2); } }
    }
}

constexpr int GS = 72;
template <int MIX> struct GlaCfg;
template <> struct GlaCfg<0> { static constexpr int PITCH = N0, CQ = C0_GQ, CK = C0_GK, CV = C0_GV, CG = C0_GR, OUTC = 512; };
template <> struct GlaCfg<1> { static constexpr int PITCH = N1, CQ = C1_HQ, CK = C1_HF, CV = C1_HI, CG = C1_HG, OUTC = 0; };
template <> struct GlaCfg<2> { static constexpr int PITCH = N1, CQ = C1_RQ, CK = C1_RK, CV = C1_RV, CG = C1_RG, OUTC = 512; };

__device__ __forceinline__ float logsigmoid_f(float z) { return fminf(z, 0.f) - log1pf(expf(-fabsf(z))); }

template <int MIX>
__device__ __forceinline__ void gla_load(Frame& F, int b, int head, int n, float (&q)[8], float (&k)[8], float (&bb)[8], float& blast, LAS float* part, bool need_q) {
    typedef GlaCfg<MIX> C; const Args& A = *F.a;
    const h16* Hh = (const h16*)(F.ws + WS_H); const int d = F.lane, w = F.wave;
    const size_t row0 = (size_t)b * SEQ + n * 64 + 8 * w; const int col = head * 64 + d;
    float la[8];
    if (MIX == 0) {
        float wg[16];
#pragma unroll
        for (int r = 0; r < 16; ++r) wg[r] = A.in[I_GLAWG][r * 256 + col];
        const float bg = A.in[I_GLABG][col];
#pragma unroll
        for (int i = 0; i < 8; ++i) { const h16* hr = Hh + (row0 + i) * C::PITCH;
            q[i] = need_q ? (float)hr[C::CQ + col] * 0.125f : 0.f; k[i] = (float)hr[C::CK + col];
            const h16x8 g0 = *(const h16x8*)(hr + C0_GA), g1 = *(const h16x8*)(hr + C0_GA + 8); float z = bg;
#pragma unroll
            for (int r = 0; r < 8; ++r) z += (float)g0[r] * wg[r] + (float)g1[r] * wg[8 + r];
            la[i] = logsigmoid_f(z) * (1.f / 16.f); }
    } else if (MIX == 1) {
        const float g0 = A.in[I_HGAMMA][col], g1 = A.in[I_HGAMMA][256 + col]; const float lb = 1.f / (1.f + expf(g0 - g1));
#pragma unroll
        for (int i = 0; i < 8; ++i) { const h16* hr = Hh + (row0 + i) * C::PITCH;
            q[i] = need_q ? (float)hr[C::CQ + col] : 0.f; const float hf = (float)hr[C::CK + col];
            const float f = lb + (1.f - lb) / (1.f + expf(-hf)); la[i] = logf(f); k[i] = 1.f - f; }
    } else {
        const float lg = log1pf(-exp2f(-5.f - (float)head));
        const float* rc = (const float*)(F.ws + WS_ROPE); const float* rs = rc + SEQ * 32;
#pragma unroll
        for (int i = 0; i < 8; ++i) { const h16* hr = Hh + (row0 + i) * C::PITCH; const int pos = n * 64 + 8 * w + i;
            const float cs = rc[pos * 32 + (d & 31)], sn = rs[pos * 32 + (d & 31)];
            const float xq = need_q ? (float)hr[C::CQ + col] : 0.f, xk = (float)hr[C::CK + col];
            const float pq = __shfl_xor(xq, 32), pk = __shfl_xor(xk, 32);
            q[i] = d < 32 ? xq * cs - pq * sn : pq * sn + xq * cs;
            k[i] = (d < 32 ? xk * cs - pk * sn : pk * sn + xk * cs) * 0.125f;
            la[i] = lg; }
    }
    float c = 0.f;
#pragma unroll
    for (int i = 0; i < 8; ++i) { c += la[i]; bb[i] = c; }
    part[w * 64 + d] = c;
    __syncthreads();
    float pre = 0.f, tot = 0.f;
#pragma unroll
    for (int w2 = 0; w2 < 8; ++w2) { const float pv = part[w2 * 64 + d]; tot += pv; if (w2 < w) pre += pv; }
#pragma unroll
    for (int i = 0; i < 8; ++i) bb[i] += pre;
    blast = tot;
}
template <int MIX>
__device__ __forceinline__ void gla_stage_vt(Frame& F, int b, int head, int n, LAS h16* Vt_l) {
    typedef GlaCfg<MIX> C; const h16* Hh = (const h16*)(F.ws + WS_H);
#pragma unroll
    for (int i = 0; i < 2; ++i) { const int id = F.tid + i * NTHR, r = id >> 4, ch = id & 15;
        const h16x8 v = *(const h16x8*)(Hh + ((size_t)b * SEQ + n * 64 + r) * C::PITCH + C::CV + head * 128 + ch * 8);
#pragma unroll
        for (int k2 = 0; k2 < 8; ++k2) Vt_l[(ch * 8 + k2) * GS + r] = v[k2]; }
}

template <int MIX>
__device__ __forceinline__ void gla_a_unit(Frame& F, int gidx, int b, int head, int n, h16* UT, float* DV) {
    LAS h16* KT_l = (LAS h16*)F.lds;
    LAS h16* Vt_l = (LAS h16*)(F.lds + 9216);
    LAS float* part = (LAS float*)(F.lds + 9216 + 18432);
    float q[8], k[8], bb[8], blast;
    __syncthreads();
    gla_load<MIX>(F, b, head, n, q, k, bb, blast, part, false);
    { h16x8 kv;
#pragma unroll
      for (int i = 0; i < 8; ++i) kv[i] = (h16)(k[i] * __expf(blast - bb[i]));
      *(LAS h16x8*)(KT_l + F.lane * GS + 8 * F.wave) = kv; }
    gla_stage_vt<MIX>(F, b, head, n, Vt_l);
    if (F.wave == 0) DV[((size_t)gidx * 256 + n) * 64 + F.lane] = __expf(blast);
    __syncthreads();
    const int fr = F.lane & 15, fq = F.lane >> 4, w = F.wave;
    const h16x8 a0 = *(const LAS h16x8*)(Vt_l + (16 * w + fr) * GS + 8 * fq), a1 = *(const LAS h16x8*)(Vt_l + (16 * w + fr) * GS + 32 + 8 * fq);
    h16* up = UT + ((size_t)gidx * 256 + n) * 8192;
#pragma unroll
    for (int dt = 0; dt < 4; ++dt) {
        const h16x8 b0 = *(const LAS h16x8*)(KT_l + (16 * dt + fr) * GS + 8 * fq), b1 = *(const LAS h16x8*)(KT_l + (16 * dt + fr) * GS + 32 + 8 * fq);
        f32x4 acc = (f32x4){0.f, 0.f, 0.f, 0.f};
        acc = __builtin_amdgcn_mfma_f32_16x16x32_f16(a0, b0, acc, 0, 0, 0);
        acc = __builtin_amdgcn_mfma_f32_16x16x32_f16(a1, b1, acc, 0, 0, 0);
#pragma unroll
        for (int r = 0; r < 4; ++r) up[(16 * w + 4 * fq + r) * 64 + 16 * dt + fr] = (h16)acc[r];
    }
}

__device__ __forceinline__ void gla_scan_unit(Frame& F, int u, const h16* UT, const float* DV, h16* ST) {
    const int gidx = u >> 2, e = (u & 3) * 32 + (F.tid >> 4), d4 = (F.tid & 15) * 4;
    const h16* up = UT + (size_t)gidx * 256 * 8192 + e * 64 + d4; h16* sp = ST + (size_t)gidx * 256 * 8192 + e * 64 + d4; const float* dp = DV + (size_t)gidx * 256 * 64 + d4;
    f32x4 S = (f32x4){0.f, 0.f, 0.f, 0.f};
    for (int nb = 0; nb < 256; nb += 8) {
        h16x4 uu[8]; f32x4 dd[8];
#pragma unroll
        for (int j = 0; j < 8; ++j) { uu[j] = *(const h16x4*)(up + (size_t)(nb + j) * 8192); dd[j] = *(const f32x4*)(dp + (nb + j) * 64); }
#pragma unroll
        for (int j = 0; j < 8; ++j) { h16x4 o; o[0] = (h16)S[0]; o[1] = (h16)S[1]; o[2] = (h16)S[2]; o[3] = (h16)S[3]; *(h16x4*)(sp + (size_t)(nb + j) * 8192) = o;
#pragma unroll
            for (int c = 0; c < 4; ++c) S[c] = S[c] * dd[j][c] + (float)uu[j][c]; }
    }
}

template <int MIX>
__device__ __forceinline__ void gla_c_unit(Frame& F, int gidx, int b, int head, int n, const h16* ST, h16* MX, const float* gw) {
    typedef GlaCfg<MIX> C;
    LAS h16* Qb_l = (LAS h16*)F.lds;
    LAS __bf16* QI_l = (LAS __bf16*)(F.lds + 9216);
    LAS __bf16* KI_l = (LAS __bf16*)(F.lds + 18432);
    LAS h16* P_l = (LAS h16*)(F.lds + 55296);
    LAS h16* Vt_l = (LAS h16*)(F.lds + 64512);
    LAS float* part = (LAS float*)(F.lds + 82944);
    LAS float* rI = (LAS float*)(F.lds + 84992);
    LAS float* stats = (LAS float*)(F.lds + 86016);
    float q[8], k[8], bb[8], blast;
    __syncthreads();
    gla_load<MIX>(F, b, head, n, q, k, bb, blast, part, true);
    const int d = F.lane, w = F.wave;
    if ((w & 1) == 0) rI[(w >> 1) * 64 + d] = bb[0];
    { unsigned zz = 0u; asm volatile("" : "+v"(zz)); const u32x4 z4 = (u32x4){zz, zz, zz, zz}; LAS u32x4* pz = (LAS u32x4*)P_l; pz[F.tid] = z4; if (F.tid < 64) pz[512 + F.tid] = z4; }
    gla_stage_vt<MIX>(F, b, head, n, Vt_l);
    __syncthreads();
    { const int I = w >> 1; float r[4];
#pragma unroll
      for (int I2 = 0; I2 < 4; ++I2) r[I2] = rI[I2 * 64 + d];
#pragma unroll
      for (int i = 0; i < 8; ++i) { const int t = 8 * w + i;
          Qb_l[t * GS + d] = (h16)(q[i] * __expf(bb[i]));
          QI_l[t * GS + d] = (__bf16)(q[i] * __expf(bb[i] - r[I]));
#pragma unroll
          for (int I2 = 0; I2 < 4; ++I2) if (I2 >= I) KI_l[(I2 * 64 + t) * GS + d] = (__bf16)(k[i] * __expf(fminf(r[I2] - bb[i], 80.f))); } }
    __syncthreads();
    const int fr = F.lane & 15, fq = F.lane >> 4;
    for (int p = w; p < 10; p += 8) {
        const int I = p >= 6 ? 3 : (p >= 3 ? 2 : (p >= 1 ? 1 : 0)), J = p - (I * (I + 1)) / 2;
        const LAS __bf16* ap = QI_l + (16 * I + fr) * GS + 8 * fq; const LAS __bf16* bp = KI_l + (I * 64 + 16 * J + fr) * GS + 8 * fq;
        f32x4 acc = (f32x4){0.f, 0.f, 0.f, 0.f};
        acc = __builtin_amdgcn_mfma_f32_16x16x32_bf16(*(const LAS b16x8*)ap, *(const LAS b16x8*)bp, acc, 0, 0, 0);
        acc = __builtin_amdgcn_mfma_f32_16x16x32_bf16(*(const LAS b16x8*)(ap + 32), *(const LAS b16x8*)(bp + 32), acc, 0, 0, 0);
#pragma unroll
        for (int r = 0; r < 4; ++r) { const int tl = 4 * fq + r; const float v = (I == J && fr > tl) ? 0.f : acc[r]; P_l[(16 * I + tl) * GS + 16 * J + fr] = (h16)v; }
    }
    __syncthreads();
    const int tt = w >> 1, eh = w & 1;
    const h16x8 p0 = *(const LAS h16x8*)(P_l + (16 * tt + fr) * GS + 8 * fq), p1 = *(const LAS h16x8*)(P_l + (16 * tt + fr) * GS + 32 + 8 * fq);
    const h16x8 qb0 = *(const LAS h16x8*)(Qb_l + (16 * tt + fr) * GS + 8 * fq), qb1 = *(const LAS h16x8*)(Qb_l + (16 * tt + fr) * GS + 32 + 8 * fq);
    const h16* sp = ST + ((size_t)gidx * 256 + n) * 8192;
    f32x4 o[4]; float s1[4] = {0.f, 0.f, 0.f, 0.f}, s2[4] = {0.f, 0.f, 0.f, 0.f};
#pragma unroll
    for (int et = 0; et < 4; ++et) { const int e0 = 64 * eh + 16 * et;
        const h16x8 v0 = *(const LAS h16x8*)(Vt_l + (e0 + fr) * GS + 8 * fq), v1 = *(const LAS h16x8*)(Vt_l + (e0 + fr) * GS + 32 + 8 * fq);
        const h16x8 t0 = *(const h16x8*)(sp + (e0 + fr) * 64 + 8 * fq), t1 = *(const h16x8*)(sp + (e0 + fr) * 64 + 32 + 8 * fq);
        f32x4 acc = (f32x4){0.f, 0.f, 0.f, 0.f};
        acc = __builtin_amdgcn_mfma_f32_16x16x32_f16(p0, v0, acc, 0, 0, 0);
        acc = __builtin_amdgcn_mfma_f32_16x16x32_f16(p1, v1, acc, 0, 0, 0);
        acc = __builtin_amdgcn_mfma_f32_16x16x32_f16(qb0, t0, acc, 0, 0, 0);
        acc = __builtin_amdgcn_mfma_f32_16x16x32_f16(qb1, t1, acc, 0, 0, 0);
        o[et] = acc;
#pragma unroll
        for (int r = 0; r < 4; ++r) { s1[r] += acc[r]; s2[r] += acc[r] * acc[r]; } }
#pragma unroll
    for (int r = 0; r < 4; ++r) {
#pragma unroll
        for (int x = 1; x < 16; x <<= 1) { s1[r] += __shfl_xor(s1[r], x); s2[r] += __shfl_xor(s2[r], x); }
        if (fr == 0) { const int t = 16 * tt + 4 * fq + r; stats[(t * 2 + eh) * 2] = s1[r]; stats[(t * 2 + eh) * 2 + 1] = s2[r]; } }
    __syncthreads();
    const h16* Hh = (const h16*)(F.ws + WS_H);
#pragma unroll
    for (int r = 0; r < 4; ++r) { const int t = 16 * tt + 4 * fq + r;
        const float a1 = stats[(t * 2) * 2] + stats[(t * 2 + 1) * 2], a2 = stats[(t * 2) * 2 + 1] + stats[(t * 2 + 1) * 2 + 1];
        float mean = 0.f, rstd;
        if (MIX == 2) { mean = a1 * (1.f / 128.f); const float var = fmaxf(a2 * (1.f / 128.f) - mean * mean, 0.f); rstd = 1.f / sqrtf(var + HEAD_EPS); }
        else rstd = 1.f / sqrtf(a2 * (1.f / 128.f) + HEAD_EPS);
        const size_t row = (size_t)b * SEQ + n * 64 + t;
#pragma unroll
        for (int et = 0; et < 4; ++et) { const int e = 64 * eh + 16 * et + fr; const float g = (float)Hh[row * C::PITCH + C::CG + head * 128 + e];
            const float y = (o[et][r] - mean) * rstd * gw[head * 128 + e] * pg8::silu_f(g);
            MX[row * DM + C::OUTC + head * 128 + e] = (h16)y; } }
}

__device__ __forceinline__ void p_xconv_gather(Frame& F) {
    const Args& A = *F.a; unsigned char* ws = F.ws;
    LAS float* scr = (LAS float*)(F.lds + F.wave * 16384);
    LAS int* ps_l = (LAS int*)(F.lds + LDS_X_OFF);
    const int gw = F.vcu * NWAVES + F.wave, NGW = F.G * NWAVES;
    if (F.tid == 0) {
        int acc = 0; int* meta = (int*)(ws + WS_META);
        for (int e = 0; e < 8; ++e) { const int c = (int)__hip_atomic_load(F.ctl + CW_MOECNT + e, RLX_AGENT); ps_l[e] = acc;
            if (blockIdx.x == 0) { meta[e] = c; meta[8 + e] = acc; const int np = (c + 255) >> 8; for (int p = 0; p < np; ++p) meta[32 + (acc >> 8) + p] = e; }
            acc += ((c + 255) >> 8) << 8; }
        if (blockIdx.x == 0) meta[16] = acc >> 8;
    }
    __syncthreads();
    { const h16* xa = (const h16*)(ws + WS_XA); h16* xs = (h16*)(ws + WS_XS); int* route = (int*)(ws + WS_ROUTE); int* rowslot = (int*)(ws + WS_ROWSLOT);
      for (int t = gw; t < M; t += NGW) { const int* rr = route + (size_t)t * 8; const int r0 = ps_l[rr[0]] + rr[1], r1 = ps_l[rr[2]] + rr[3];
          const h16x8 a = *(const h16x8*)(xa + (size_t)t * DM + F.lane * 8), b = *(const h16x8*)(xa + (size_t)t * DM + 512 + F.lane * 8);
          *(h16x8*)(xs + (size_t)r0 * DM + F.lane * 8) = a; *(h16x8*)(xs + (size_t)r0 * DM + 512 + F.lane * 8) = b;
          *(h16x8*)(xs + (size_t)r1 * DM + F.lane * 8) = a; *(h16x8*)(xs + (size_t)r1 * DM + 512 + F.lane * 8) = b;
          if (F.lane == 0) { rowslot[r0] = 2 * t; rowslot[r1] = 2 * t + 1; } } }
    constexpr int TI = 1792, NT = 8 * 3 * TI;
    for (int it = gw; it < NT; it += NGW) {
        const int e = it / (3 * TI), r = it % (3 * TI), which = r / TI, item = r % TI;
        if (which == 0) transpose_item(A.in[I_XW1] + (size_t)e * 1024 * FE, FE, (h16*)(ws + WS_E13) + (size_t)e * 7168 * 1024, 1024, 2, scr, item, F.lane);
        else if (which == 1) transpose_item(A.in[I_XW3] + (size_t)e * 1024 * FE, FE, (h16*)(ws + WS_E13) + (size_t)e * 7168 * 1024, 1024, 3, scr, item, F.lane);
        else transpose_item(A.in[I_XW2] + (size_t)e * FE * 1024, 1024, (h16*)(ws + WS_E2) + (size_t)e * 1024 * FE, FE, 0, scr, item, F.lane);
    }
}

constexpr int NPH = 31;
__global__ void __launch_bounds__(NTHR, 2) hyb_fwd(Args args) {
    extern __shared__ __attribute__((aligned(16))) unsigned char lds_raw[];
    Frame F;
    F.lds = (LAS unsigned char*)lds_raw; F.tid = threadIdx.x; F.lane = F.tid & 63; F.wave = __builtin_amdgcn_readfirstlane(F.tid >> 6);
    F.G = gridDim.x; { const int bx = blockIdx.x; F.vcu = (F.G % 8 == 0) ? (bx % 8) * (F.G / 8) + bx / 8 : bx; }
    F.ws = args.ws; F.ctl = (gu32*)(args.ws + WS_CTL); F.a = &args;
    if (F.tid < 64) ((LAS unsigned*)(F.lds + LDSCTL_OFF))[F.tid] = 0u;
    __syncthreads();
    const int lo = args.ph_lo, hi = args.ph_hi;
    XcdBarrier bar; bar.bar = (unsigned*)(F.ctl + CW_BAR); bar.x = 0; bar.st = (volatile LAS unsigned*)(F.lds + LDSCTL_OFF + 32);
    if (hi - lo > 1) bar = xcd_barrier_post((unsigned*)(F.ctl + CW_BAR), (volatile LAS unsigned*)(F.lds + LDSCTL_OFF + 32));
#ifndef PHMASK
#define PHMASK 0x7fffffffull
#endif
#define IN(k) (((PHMASK >> ((k) >= 20 && (k) < 28 ? 20 + ((k) & 1) : (k))) & 1ull) && lo <= (k) && (k) < hi)
#define SEAM(k) do { if (IN(k) && IN((k) + 1)) xcd_barrier(bar); } while (0)
#define XA ((h16*)(F.ws + WS_XA))
#define XB ((h16*)(F.ws + WS_XB))
#define Hb ((h16*)(F.ws + WS_H))
#define Yb ((h16*)(F.ws + WS_Y))
    const int cid = (int)blockIdx.x;

    if (IN(0)) { launder(F); p_prologue(F); }
    SEAM(0);
#pragma unroll 1
    for (int L = 0; L < 2; ++L) {
        const int p_in = L ? 13 : 1, p_out = L ? 17 : 6, p_lnb = L ? 28 : 10;
#define Xin (L ? XB : XA)
#define Xmid (L ? XA : XB)
#define Xffn (L ? XB : XA)
#define MXb ((h16*)(F.ws + (L ? WS_MIXIN1 : WS_MIXIN0)))
        if (IN(p_in)) { launder(F); const int N = L ? N1 : N0;
            pg8::Gemm g{Xin, (const h16*)(F.ws + (L ? WS_WIN1 : WS_WIN0)), 1024}; pg8::StaticOrder S; S.init(M, N, F.G, cid);
            pg8::EpiStoreH E{Hb, N};
            pg8::gemm_phase<pg8::EpiStoreH, pg8::StaticOrder, true>(F.lds, g, S, E); }
        SEAM(p_in);
        if (L == 0) {
            if (IN(2)) { launder(F); for (int u = F.vcu; u < 128 + 2048; u += F.G) { if (u < 128) moba_kmean_unit(F, u); else { const int v = u - 128, gi = v >> 8, n = v & 255; gla_a_unit<0>(F, gi, gi >> 2, gi & 3, n, (h16*)(F.ws + WS_U0), (float*)(F.ws + WS_DV0)); } } }
            SEAM(2);
            if (IN(3)) { launder(F); for (int u = F.vcu; u < 32 + 1008; u += F.G) { if (u < 32) gla_scan_unit(F, u, (const h16*)(F.ws + WS_U0), (const float*)(F.ws + WS_DV0), (h16*)(F.ws + WS_ST0)); else moba_select_unit(F, u - 32); } }
            SEAM(3);
            if (IN(4)) { launder(F); moba_sparse_phase(F); }
            SEAM(4);
            if (IN(5)) { launder(F); for (int u = F.vcu; u < 1024 + 2048; u += F.G) { if (u < 1024) moba_own_unit(F, u); else { const int v = u - 1024, gi = v >> 8, n = v & 255; gla_c_unit<0>(F, gi, gi >> 2, gi & 3, n, (const h16*)(F.ws + WS_ST0), MXb, args.in[I_GLAN]); } } }
            SEAM(5);
        } else {
            if (IN(14)) { launder(F); for (int u = F.vcu; u < 4096; u += F.G) { const int gi = u >> 8, n = u & 255, bh = gi & 7;
                if (gi < 8) gla_a_unit<1>(F, gi, bh >> 2, bh & 3, n, (h16*)(F.ws + WS_U1), (float*)(F.ws + WS_DV1)); else gla_a_unit<2>(F, gi, bh >> 2, bh & 3, n, (h16*)(F.ws + WS_U1), (float*)(F.ws + WS_DV1)); } }
            SEAM(14);
            if (IN(15)) { launder(F); for (int u = F.vcu; u < 64; u += F.G) gla_scan_unit(F, u, (const h16*)(F.ws + WS_U1), (const float*)(F.ws + WS_DV1), (h16*)(F.ws + WS_ST1)); }
            SEAM(15);
            if (IN(16)) { launder(F); for (int u = F.vcu; u < 4096; u += F.G) { const int gi = u >> 8, n = u & 255, bh = gi & 7;
                if (gi < 8) gla_c_unit<1>(F, gi, bh >> 2, bh & 3, n, (const h16*)(F.ws + WS_ST1), MXb, args.in[I_HNORM]); else gla_c_unit<2>(F, gi, bh >> 2, bh & 3, n, (const h16*)(F.ws + WS_ST1), MXb, args.in[I_RNORM]); } }
            SEAM(16);
        }
        if (IN(p_out)) { launder(F); pg8::Gemm g{MXb, (const h16*)(F.ws + (L ? WS_WOUT1 : WS_WOUT0)), 1024}; pg8::StaticOrder S; S.init(M, 1024, F.G, cid);
            pg8::EpiResid E{Yb, Xin};
            pg8::gemm_phase<pg8::EpiResid, pg8::StaticOrder, true>(F.lds, g, S, E); }
        SEAM(p_out);
        if (IN(p_out + 1)) { launder(F); __syncthreads();
            if (L == 0) ln_phase<0>(F, Yb, args.in[I_LMG], args.in[I_LMB], Xmid, nullptr, nullptr);
            else ln_phase<1>(F, Yb, args.in[I_LMG] + 1024, args.in[I_LMB] + 1024, Xmid, nullptr, nullptr); }
        SEAM(p_out + 1);
        if (L == 0) {
            if (IN(8)) { launder(F); pg8::Gemm g{Xmid, (const h16*)(F.ws + WS_W13_0), 1024}; pg8::StaticOrder S; S.init(M, 2 * FDP, F.G, cid);
                pg8::EpiSwiGLU E{(h16*)(F.ws + WS_HID), FDP};
                pg8::gemm_phase<pg8::EpiSwiGLU, pg8::StaticOrder, true>(F.lds, g, S, E); }
            SEAM(8);
            if (IN(9)) { launder(F); pg8::Gemm g{(const h16*)(F.ws + WS_HID), (const h16*)(F.ws + WS_W2_0), FDP}; pg8::StaticOrder S; S.init(M, 1024, F.G, cid);
                pg8::EpiResid E{Yb, Xmid};
                pg8::gemm_phase<pg8::EpiResid, pg8::StaticOrder, true>(F.lds, g, S, E); }
            SEAM(9);
        } else {
            if (IN(19)) { launder(F); __syncthreads(); p_xconv_gather(F); }
            SEAM(19);
#define meta ((const int*)(F.ws + WS_META))
#pragma unroll 1
            for (int q = 0; q < MOE_PASSES; ++q) {
                const int pu = 20 + 2 * q;
                if (IN(pu)) { launder(F); const int PT = __builtin_amdgcn_readfirstlane(meta[16]); const int P0 = MOE_PPP * q, P1 = (P0 + MOE_PPP) < PT ? (P0 + MOE_PPP) : PT;
                    pg8::Gemm g{(const h16*)(F.ws + WS_XS), (const h16*)(F.ws + WS_E13), 1024}; pg8::MoeOrder S; S.init(P0, P1, 28, F.G, cid, 1, meta + 32);
                    pg8::EpiSwiGLU E{(h16*)(F.ws + WS_HQ), FE};
                    pg8::gemm_phase<pg8::EpiSwiGLU, pg8::MoeOrder, true>(F.lds, g, S, E); }
                SEAM(pu);
                if (IN(pu + 1)) { launder(F); const int PT = __builtin_amdgcn_readfirstlane(meta[16]); const int P0 = MOE_PPP * q, P1 = (P0 + MOE_PPP) < PT ? (P0 + MOE_PPP) : PT;
                    pg8::Gemm g{(const h16*)(F.ws + WS_HQ), (const h16*)(F.ws + WS_E2), FE}; pg8::MoeOrder S; S.init(P0, P1, 4, F.G, cid, 0, meta + 32);
                    pg8::EpiMoeDown E{(h16*)args.out, (const int*)(F.ws + WS_ROWSLOT), meta};
                    pg8::gemm_phase<pg8::EpiMoeDown, pg8::MoeOrder, true>(F.lds, g, S, E); }
                SEAM(pu + 1);
            }
        }
        if (IN(p_lnb)) { launder(F); __syncthreads();
            if (L == 0) ln_phase<0>(F, Yb, args.in[I_LFG], args.in[I_LFB], Xffn, nullptr, nullptr);
            else ln_phase<2>(F, nullptr, args.in[I_LFG] + 1024, args.in[I_LFB] + 1024, Xffn, Xmid, (const h16*)args.out); }
        SEAM(p_lnb);
        if (IN(p_lnb + 1)) { launder(F); pg8::Gemm g{(const h16*)(F.ws + WS_PH) + (size_t)L * M * PLE, (const h16*)(F.ws + (L ? WS_WP1 : WS_WP0)), PLE}; pg8::StaticOrder S; S.init(M, 1024, F.G, cid);
            pg8::EpiStoreH E{(h16*)(F.ws + WS_PP), 1024};
            pg8::gemm_phase<pg8::EpiStoreH, pg8::StaticOrder, true>(F.lds, g, S, E); }
        SEAM(p_lnb + 1);
        if (IN(p_lnb + 2)) { launder(F); pg8::Gemm g{Xffn, (const h16*)(F.ws + (L ? WS_WG1 : WS_WG0)), 1024}; pg8::StaticOrder S; S.init(M, 1024, F.G, cid);
            pg8::EpiPle E{Xffn, (const h16*)(F.ws + WS_PP), L ? XA : XB, args.out, L};
            pg8::gemm_phase<pg8::EpiPle, pg8::StaticOrder, true>(F.lds, g, S, E); }
        if (L == 0) SEAM(12);
    }
#undef XA
#undef XB
#undef Hb
#undef Yb
#undef Xin
#undef Xmid
#undef Xffn
#undef MXb
#undef meta
#undef IN
#undef SEAM
}

#ifndef MK_PER_PHASE
#define MK_PER_PHASE 0
#endif
extern "C" void kernel_launch(void* const* d_in, const int* in_sizes, int n_in, void* d_out, int out_size, void* d_ws, size_t ws_size, hipStream_t stream) {
    static int grid = 0;
    if (grid == 0) {
        if (n_in != 27 || in_sizes[0] != M * DM || out_size != M * DM || ws_size < WS_END) { fprintf(stderr, "kernel_launch: unexpected shapes (n_in %d, in0 %d, out %d, ws %zu); nothing launched\n", n_in, n_in > 0 ? in_sizes[0] : -1, out_size, ws_size); grid = -1; return; }
        int dev = 0, cus = 0, per_cu = 0;
        if (hipGetDevice(&dev) != hipSuccess || hipDeviceGetAttribute(&cus, hipDeviceAttributeMultiprocessorCount, dev) != hipSuccess) { grid = -1; return; }
        if (hipFuncSetAttribute((const void*)hyb_fwd, hipFuncAttributeMaxDynamicSharedMemorySize, LDS_BYTES) != hipSuccess) { fprintf(stderr, "kernel_launch: hipFuncSetAttribute failed\n"); grid = -1; return; }
        if (hipOccupancyMaxActiveBlocksPerMultiprocessor(&per_cu, (const void*)hyb_fwd, NTHR, LDS_BYTES) != hipSuccess || per_cu < 1) fprintf(stderr, "kernel_launch: occupancy query reports %d\n", per_cu);
        (void)hipGetLastError();
        grid = cus;
    }
    if (grid < 0) return;
    if (hipMemsetAsync((char*)d_ws + WS_CTL, 0, CTL_ZERO_BYTES, stream) != hipSuccess) return;
    Args a{};
    for (int i = 0; i < 27; ++i) a.in[i] = (const float*)d_in[i];
    a.out = (float*)d_out; a.ws = (unsigned char*)d_ws;
#if MK_PER_PHASE
    for (int ph = 0; ph < NPH; ++ph) { a.ph_lo = ph; a.ph_hi = ph + 1; hipLaunchKernelGGL(hyb_fwd, dim3(grid), dim3(NTHR), LDS_BYTES, stream, a); }
#else
    a.ph_lo = 0; a.ph_hi = NPH; hipLaunchKernelGGL(hyb_fwd, dim3(grid), dim3(NTHR), LDS_BYTES, stream, a);
#endif
}
```

```cpp
#include <hip/hip_runtime.h>
#include <cstdio>
#include <cstdint>

#define LAS __attribute__((address_space(3)))
#define GAS __attribute__((address_space(1)))
typedef _Float16 h16;
typedef _Float16 h16x8 __attribute__((ext_vector_type(8)));
typedef _Float16 h16x4 __attribute__((ext_vector_type(4)));
typedef _Float16 h16x2 __attribute__((ext_vector_type(2)));
typedef __bf16 b16x8 __attribute__((ext_vector_type(8)));
typedef float f32x4 __attribute__((ext_vector_type(4)));
typedef float f32x2 __attribute__((ext_vector_type(2)));
typedef unsigned u32x4 __attribute__((ext_vector_type(4)));
typedef unsigned u32x2 __attribute__((ext_vector_type(2)));
typedef GAS unsigned gu32;
#define RLX_AGENT __ATOMIC_RELAXED, __HIP_MEMORY_SCOPE_AGENT
#define LDS_WAIT() asm volatile("s_waitcnt lgkmcnt(0)" ::: "memory")
#define VM_WAIT() asm volatile("s_waitcnt vmcnt(0)" ::: "memory")

constexpr int BATCH = 2, SEQ = 16384, DM = 1024, M = BATCH * SEQ;
constexpr int NWAVES = 8, NTHR = 512;
constexpr float DN_ALPHA = 1.4142135623730951f;
constexpr float LN_EPS = 1e-5f, HEAD_EPS = 1e-6f;
constexpr int N0 = 3328;
constexpr int N1 = 3072;
constexpr int C0_MQ = 0, C0_MK = 512, C0_MV = 1024, C0_GQ = 1536, C0_GK = 1792, C0_GV = 2048, C0_GR = 2560, C0_GA = 3072;
constexpr int C1_HQ = 0, C1_HF = 256, C1_HI = 512, C1_HG = 1024, C1_RQ = 1536, C1_RK = 1792, C1_RV = 2048, C1_RG = 2560;
constexpr int FD = 2752, FDP = 2816;
constexpr int FE = 3584, NEXP = 8;
constexpr int PLE = 256;
constexpr int MOE_PANELS = 264;
constexpr int MOE_PASSES = 5, MOE_PPP = 64;

namespace pg8 {
constexpr int BM = 256, BK = 64, HALF = 128, HTB = HALF * BK * 2, STAGE_BYTES = 8 * HTB, NXCD = 8, WGM = 8;
__host__ __device__ __forceinline__ int lds_byte(int r, int c) { const int st = (r >> 4) * 2 + (c >> 5), rr = r & 15, cc = c & 31, ob = rr * 64 + cc * 2; return st * 1024 + (ob ^ (((ob >> 9) & 1) << 5)); }
__host__ __device__ __forceinline__ void stage_rc(int b, int& R, int& C) { const int st = b / 1024, sb = b % 1024, swz = sb ^ (((sb >> 9) & 1) << 5); R = (st >> 1) * 16 + swz / 64; C = (st & 1) * 32 + (swz % 64) / 2; }
__host__ __device__ __forceinline__ int perm32(int rho) { const int n = rho >> 4, i = rho & 15; return 8 * (i >> 2) + 4 * n + (i & 3); }

struct Unit { int pa, pb, pm, pn; };
struct Gemm { const h16* A; const h16* Bt; int K; };

struct StaticOrder {
    int nM, nN, nwg, G, c;
    __device__ void init(int Mrows, int N, int G_, int c_) { nM = Mrows / BM; nN = N / BM; nwg = nM * nN; G = G_; c = c_; }
    __device__ bool next(int i, Unit& u) const {
        const long L = (long)i * G + c; if (L >= nwg) return false;
        int wgid = (int)L; { const int q = nwg / NXCD, r = nwg % NXCD, xcd = wgid % NXCD, off = wgid / NXCD; wgid = (xcd < r ? xcd * (q + 1) : r * (q + 1) + (xcd - r) * q) + off; }
        const int nig = WGM * nN, gid = wgid / nig, fm = gid * WGM, gsz = (nM - fm) < WGM ? (nM - fm) : WGM;
        u.pm = fm + ((wgid % nig) % gsz); u.pn = (wgid % nig) / gsz; u.pa = u.pm; u.pb = u.pn; return true;
    }
};
struct MoeOrder {
    int P0, nM, nN, nwg, G, c, up; const int* pexp;
    __device__ void init(int P0_, int P1_, int nN_, int G_, int c_, int up_, const int* pexp_) { P0 = P0_; nM = P1_ - P0_; if (nM < 0) nM = 0; nN = nN_; nwg = nM * nN; G = G_; c = c_; up = up_; pexp = pexp_; }
    __device__ bool next(int i, Unit& u) const {
        const long L = (long)i * G + c; if (L >= nwg) return false;
        int wgid = (int)L; { const int q = nwg / NXCD, r = nwg % NXCD, xcd = wgid % NXCD, off = wgid / NXCD; wgid = (xcd < r ? xcd * (q + 1) : r * (q + 1) + (xcd - r) * q) + off; }
        const int nig = WGM * nN, gid = wgid / nig, fm = gid * WGM, gsz = (nM - fm) < WGM ? (nM - fm) : WGM;
        const int pl = fm + ((wgid % nig) % gsz), pn = (wgid % nig) / gsz;
        const int e = __builtin_amdgcn_readfirstlane(pexp[P0 + pl]);
        u.pn = pn; u.pb = e * nN + pn;
        if (up) { u.pa = P0 + pl; u.pm = pl; } else { u.pa = pl; u.pm = P0 + pl; }
        return true;
    }
};

__device__ __forceinline__ h16x8 pack8(const f32x4 a, const f32x4 b) { h16x8 w; w[0] = (h16)a[0]; w[1] = (h16)a[1]; w[2] = (h16)a[2]; w[3] = (h16)a[3]; w[4] = (h16)b[0]; w[5] = (h16)b[1]; w[6] = (h16)b[2]; w[7] = (h16)b[3]; return w; }
__device__ __forceinline__ float silu_f(float x) { return x * __builtin_amdgcn_rcpf(1.0f + __expf(-x)); }
__device__ __forceinline__ float sigmoid_f(float x) { return __builtin_amdgcn_rcpf(1.0f + __expf(-x)); }

struct EpiStoreH {
    h16* O; int ldc;
    __device__ __forceinline__ void operator()(const f32x4 (&acc)[2][2][4][2], const Unit& u, int wr, int wc, int fr, int fq) const {
        const int row0 = u.pm * BM + wr * 64 + fr, col0 = u.pn * BM + wc * 32 + 8 * fq;
#pragma unroll
        for (int ai = 0; ai < 2; ++ai)
#pragma unroll
            for (int m = 0; m < 4; ++m) { h16* rowp = O + (size_t)(row0 + ai * HALF + m * 16) * ldc + col0;
#pragma unroll
                for (int bj = 0; bj < 2; ++bj) *(h16x8*)(rowp + bj * HALF) = pack8(acc[ai][bj][m][0], acc[ai][bj][m][1]); }
    }
};
struct EpiResid {
    h16* Y; const h16* R;
    __device__ __forceinline__ void operator()(const f32x4 (&acc)[2][2][4][2], const Unit& u, int wr, int wc, int fr, int fq) const {
        const int row0 = u.pm * BM + wr * 64 + fr, col0 = u.pn * BM + wc * 32 + 8 * fq;
#pragma unroll
        for (int ai = 0; ai < 2; ++ai)
#pragma unroll
            for (int m = 0; m < 4; ++m) { const size_t off = (size_t)(row0 + ai * HALF + m * 16) * DM + col0;
#pragma unroll
                for (int bj = 0; bj < 2; ++bj) { const h16x8 r = *(const h16x8*)(R + off + bj * HALF); const f32x4 a = acc[ai][bj][m][0], b = acc[ai][bj][m][1]; h16x8 w;
#pragma unroll
                    for (int j = 0; j < 4; ++j) { w[j] = (h16)(DN_ALPHA * (float)r[j] + a[j]); w[4 + j] = (h16)(DN_ALPHA * (float)r[4 + j] + b[j]); }
                    *(h16x8*)(Y + off + bj * HALF) = w; }
                asm volatile("" ::: "memory"); }
    }
};
struct EpiSwiGLU {
    h16* Hd; int ldh;
    __device__ __forceinline__ void operator()(const f32x4 (&acc)[2][2][4][2], const Unit& u, int wr, int wc, int fr, int fq) const {
        const int row0 = u.pm * BM + wr * 64 + fr, col0 = u.pn * HALF + wc * 32 + 8 * fq;
#pragma unroll
        for (int ai = 0; ai < 2; ++ai)
#pragma unroll
            for (int m = 0; m < 4; ++m) { h16x8 w;
#pragma unroll
                for (int n = 0; n < 2; ++n)
#pragma unroll
                    for (int j = 0; j < 4; ++j) w[4 * n + j] = (h16)(silu_f(acc[ai][0][m][n][j]) * acc[ai][1][m][n][j]);
                *(h16x8*)(Hd + (size_t)(row0 + ai * HALF + m * 16) * ldh + col0) = w; }
    }
};
struct EpiPle {
    const h16* X; const h16* PP; h16* Oh; float* Of; int fin;
    __device__ __forceinline__ void operator()(const f32x4 (&acc)[2][2][4][2], const Unit& u, int wr, int wc, int fr, int fq) const {
        const int row0 = u.pm * BM + wr * 64 + fr, col0 = u.pn * BM + wc * 32 + 8 * fq;
#pragma unroll
        for (int ai = 0; ai < 2; ++ai)
#pragma unroll
            for (int m = 0; m < 4; ++m) { const size_t off = (size_t)(row0 + ai * HALF + m * 16) * DM + col0;
#pragma unroll
                for (int bj = 0; bj < 2; ++bj) { const h16x8 x = *(const h16x8*)(X + off + bj * HALF), p = *(const h16x8*)(PP + off + bj * HALF); const f32x4 a = acc[ai][bj][m][0], b = acc[ai][bj][m][1];
                    f32x4 o0, o1;
#pragma unroll
                    for (int j = 0; j < 4; ++j) { o0[j] = (float)x[j] + sigmoid_f(a[j]) * (float)p[j]; o1[j] = (float)x[4 + j] + sigmoid_f(b[j]) * (float)p[4 + j]; }
                    if (fin) { *(f32x4*)(Of + off + bj * HALF) = o0; *(f32x4*)(Of + off + bj * HALF + 4) = o1; }
                    else *(h16x8*)(Oh + off + bj * HALF) = pack8(o0, o1);
                    asm volatile("" ::: "memory"); } }
    }
};
struct EpiMoeDown {
    h16* ys; const int* rowslot; const int* meta;
    __device__ __forceinline__ void operator()(const f32x4 (&acc)[2][2][4][2], const Unit& u, int wr, int wc, int fr, int fq) const {
        const int row0 = u.pm * BM + wr * 64 + fr, col0 = u.pn * BM + wc * 32 + 8 * fq;
        const int e = u.pb >> 2;
        const int lim = meta[8 + e] + meta[e];
#pragma unroll
        for (int ai = 0; ai < 2; ++ai)
#pragma unroll
            for (int m = 0; m < 4; ++m) { const int r = row0 + ai * HALF + m * 16;
                if (r < lim) { const int slot = rowslot[r]; h16* rowp = ys + (size_t)slot * DM + col0;
#pragma unroll
                    for (int bj = 0; bj < 2; ++bj) *(h16x8*)(rowp + bj * HALF) = pack8(acc[ai][bj][m][0], acc[ai][bj][m][1]); } }
    }
};

template <class Epi, class Sched, bool ALIGN_EPI>
__device__ __forceinline__ void gemm_phase(LAS unsigned char* lds, const Gemm g, const Sched& S, const Epi& E) {
    int tid_ = threadIdx.x; asm volatile("" : "+v"(tid_));
    const int tid = tid_, wid = __builtin_amdgcn_readfirstlane(tid >> 6), lane = tid & 63, wr = wid >> 2, wc = wid & 3, fr = lane & 15, fq = lane >> 4;
    const int K = g.K, nt = K / BK;
    unsigned voffA[2], voffB[2];
#pragma unroll
    for (int i = 0; i < 2; ++i) { int R, C; stage_rc(tid * 16 + i * 8192, R, C); const int Rb = (R & ~31) + perm32(R & 31);
        voffA[i] = (unsigned)(R * K + C) * 2u; voffB[i] = (unsigned)(Rb * K + C) * 2u; }
    const size_t kstep = (size_t)(BK * 2);
    const size_t hstep = (size_t)HALF * K * 2;
    const size_t tstep = 2 * hstep;
    const unsigned ldsw = (unsigned)wid * 1024u;
    const int aoff = lds_byte(wr * 64 + fr, fq * 8), boff = lds_byte(wc * 32 + fr, fq * 8);
#define PG8_SA(b, h) (((b) * 2 + (h)) * HTB)
#define PG8_SB(b, h) ((4 + (b) * 2 + (h)) * HTB)
#define PG8_STAGE(bufoff, gbase, voff) do { _Pragma("unroll") for (int _i = 0; _i < 2; ++_i) \
        __builtin_amdgcn_global_load_lds((const unsigned*)((const char*)(gbase) + (voff)[_i]), (LAS unsigned*)(lds + (bufoff) + ldsw + _i * 8192), 16, 0, 0); } while (0)
#define PG8_LDA(dst, b, h) do { _Pragma("unroll") for (int m = 0; m < 4; ++m) _Pragma("unroll") for (int k = 0; k < 2; ++k) dst[m][k] = *(const LAS h16x8*)(lds + PG8_SA(b, h) + aoff + m * 2048 + k * 1024); } while (0)
#define PG8_LDB(dst, b, h) do { _Pragma("unroll") for (int n = 0; n < 2; ++n) _Pragma("unroll") for (int k = 0; k < 2; ++k) dst[n][k] = *(const LAS h16x8*)(lds + PG8_SB(b, h) + boff + n * 2048 + k * 1024); } while (0)
#define PG8_MMA(ai, bj, At, Bt) do { __builtin_amdgcn_s_setprio(1); _Pragma("unroll") for (int m = 0; m < 4; ++m) _Pragma("unroll") for (int n = 0; n < 2; ++n) _Pragma("unroll") for (int k = 0; k < 2; ++k) \
        acc[ai][bj][m][n] = __builtin_amdgcn_mfma_f32_16x16x32_f16(Bt[n][k], At[m][k], acc[ai][bj][m][n], 0, 0, 0); __builtin_amdgcn_s_setprio(0); } while (0)
#define PG8_WAIT_V(n) asm volatile("s_waitcnt vmcnt(" #n ")" ::: "memory")
#define PG8_WAIT_L(n) asm volatile("s_waitcnt lgkmcnt(" #n ")" ::: "memory")
#define PG8_BAR __builtin_amdgcn_s_barrier()
#define PG8_SCHED __builtin_amdgcn_sched_barrier(0)
    Unit cur, nxt; int ui = 0;
    if (!S.next(0, cur)) return;
    f32x4 acc[2][2][4][2];
#pragma unroll
    for (int a = 0; a < 2; ++a)
#pragma unroll
        for (int b = 0; b < 2; ++b)
#pragma unroll
            for (int m = 0; m < 4; ++m)
#pragma unroll
                for (int n = 0; n < 2; ++n) acc[a][b][m][n] = (f32x4){0.f, 0.f, 0.f, 0.f};
    h16x8 At[4][2], B0[2][2], B1[2][2];
    const char* cA = (const char*)g.A + (size_t)cur.pa * tstep; const char* cB = (const char*)g.Bt + (size_t)cur.pb * tstep;
    PG8_STAGE(PG8_SB(0, 0), cB, voffB); PG8_STAGE(PG8_SB(0, 1), cB + hstep, voffB); PG8_STAGE(PG8_SA(0, 0), cA, voffA); PG8_STAGE(PG8_SA(0, 1), cA + hstep, voffA);
    if (wr == 1) PG8_BAR;
    PG8_WAIT_V(2); PG8_BAR;
    PG8_STAGE(PG8_SB(1, 0), cB + kstep, voffB); PG8_STAGE(PG8_SA(1, 0), cA + kstep, voffA); PG8_STAGE(PG8_SB(1, 1), cB + hstep + kstep, voffB);
    PG8_WAIT_V(6); PG8_BAR;
    for (;;) {
        const bool has_next = S.next(ui + 1, nxt);
        const char* nA = has_next ? (const char*)g.A + (size_t)nxt.pa * tstep : cA; const char* nB = has_next ? (const char*)g.Bt + (size_t)nxt.pb * tstep : cB;
        for (int t = 0; t < nt; t += 2) {
            const bool last = (t == nt - 2);
            const char* a1 = cA + (size_t)(t + 1) * kstep;
            const char* a2 = last ? nA : cA + (size_t)(t + 2) * kstep; const char* b2 = last ? nB : cB + (size_t)(t + 2) * kstep;
            const char* a3 = a2 + kstep; const char* b3 = b2 + kstep;
            PG8_LDB(B0, 0, 0); PG8_LDB(B1, 0, 1); PG8_SCHED; PG8_LDA(At, 0, 0); PG8_STAGE(PG8_SA(1, 1), a1 + hstep, voffA);
            PG8_WAIT_V(8); PG8_WAIT_L(0); PG8_BAR; PG8_MMA(0, 0, At, B0); PG8_MMA(0, 1, At, B1); PG8_BAR; PG8_SCHED;
            PG8_LDA(At, 0, 1); PG8_STAGE(PG8_SB(0, 0), b2, voffB); PG8_STAGE(PG8_SB(0, 1), b2 + hstep, voffB); PG8_STAGE(PG8_SA(0, 0), a2, voffA);
            PG8_WAIT_V(8); PG8_WAIT_L(0); PG8_BAR; PG8_MMA(1, 0, At, B0); PG8_MMA(1, 1, At, B1); PG8_BAR; PG8_SCHED;
            PG8_LDB(B0, 1, 0); PG8_LDB(B1, 1, 1); PG8_SCHED; PG8_LDA(At, 1, 0); PG8_STAGE(PG8_SA(0, 1), a2 + hstep, voffA);
            PG8_WAIT_V(8); PG8_WAIT_L(0); PG8_BAR; PG8_MMA(0, 0, At, B0); PG8_MMA(0, 1, At, B1); PG8_BAR; PG8_SCHED;
            PG8_LDA(At, 1, 1); PG8_STAGE(PG8_SB(1, 0), b3, voffB); PG8_STAGE(PG8_SB(1, 1), b3 + hstep, voffB); PG8_STAGE(PG8_SA(1, 0), a3, voffA);
            PG8_WAIT_V(8); PG8_WAIT_L(0); PG8_BAR; PG8_MMA(1, 0, At, B0); PG8_MMA(1, 1, At, B1); PG8_BAR; PG8_SCHED;
        }
        if constexpr (ALIGN_EPI) { if (wr == 0) PG8_BAR; }
        { int fr_ = fr, fq_ = fq; asm volatile("" : "+v"(fr_), "+v"(fq_)); E(acc, cur, wr, wc, fr_, fq_); }
        if (!has_next) break;
#pragma unroll
        for (int a = 0; a < 2; ++a)
#pragma unroll
            for (int b = 0; b < 2; ++b)
#pragma unroll
                for (int m = 0; m < 4; ++m)
#pragma unroll
                    for (int n = 0; n < 2; ++n) acc[a][b][m][n] = (f32x4){0.f, 0.f, 0.f, 0.f};
        cur = nxt; cA = nA; cB = nB; ++ui;
        if constexpr (ALIGN_EPI) { if (wr == 1) PG8_BAR; }
    }
    PG8_WAIT_V(0);
    if constexpr (!ALIGN_EPI) { if (wr == 0) PG8_BAR; }
    PG8_BAR;
#undef PG8_SA
#undef PG8_SB
#undef PG8_STAGE
#undef PG8_LDA
#undef PG8_LDB
#undef PG8_MMA
#undef PG8_WAIT_V
#undef PG8_WAIT_L
#undef PG8_BAR
#undef PG8_SCHED
}
}

constexpr size_t MiB = 1u << 20;
constexpr size_t WS_CTL = 0, CTL_ZERO_BYTES = 1 * MiB;
constexpr size_t WS_KMEAN = 1 * MiB;
constexpr size_t WS_BIASL = 1 * MiB + 512 * 1024;
constexpr size_t WS_META = 1 * MiB + 768 * 1024;
constexpr size_t WS_ROUTE = 2 * MiB;
constexpr size_t WS_ROWSLOT = 3 * MiB;
constexpr size_t WS_ROPE = 4 * MiB;
constexpr size_t WS_WIN0 = 8 * MiB;
constexpr size_t WS_WOUT0 = 15 * MiB;
constexpr size_t WS_W13_0 = 17 * MiB;
constexpr size_t WS_W2_0 = 28 * MiB;
constexpr size_t WS_WG0 = 34 * MiB, WS_WG1 = 36 * MiB;
constexpr size_t WS_WP0 = 38 * MiB, WS_WP1 = 38 * MiB + 512 * 1024;
constexpr size_t WS_WIN1 = 39 * MiB;
constexpr size_t WS_WOUT1 = 45 * MiB;
constexpr size_t WS_PH = 48 * MiB;
constexpr size_t WS_XA = 80 * MiB, WS_XB = 144 * MiB;
constexpr size_t WS_R = 208 * MiB;
constexpr size_t WS_H = WS_R;
constexpr size_t WS_Y = WS_R;
constexpr size_t WS_MIXIN0 = WS_R + 208 * MiB;
constexpr size_t WS_U0 = WS_R + 272 * MiB, WS_ST0 = WS_R + 304 * MiB, WS_DV0 = WS_R + 336 * MiB;
constexpr size_t WS_LIST = WS_R + 340 * MiB;
constexpr size_t WS_HID = WS_R + 64 * MiB;
constexpr size_t WS_PP = WS_R + 244 * MiB;
constexpr size_t WS_MIXIN1 = WS_R + 192 * MiB;
constexpr size_t WS_U1 = WS_R + 256 * MiB, WS_ST1 = WS_R + 320 * MiB, WS_DV1 = WS_R + 384 * MiB;
constexpr size_t WS_E2 = WS_XB;
constexpr size_t WS_E13 = WS_R;
constexpr size_t WS_XS = WS_R + 112 * MiB;
constexpr size_t WS_HQ = WS_R + 244 * MiB;
constexpr size_t WS_END = 600 * MiB;
static_assert(WS_DV1 + 1 * MiB <= WS_END && WS_HQ + (size_t)MOE_PPP * 256 * FE * 2 <= WS_END && WS_LIST + 16 * MiB <= WS_END, "ws map");
static_assert(WS_HID + (size_t)M * FDP * 2 <= WS_PP && WS_XS + (size_t)MOE_PANELS * 256 * DM * 2 <= WS_HQ, "ws map 2");
constexpr size_t DO_PO = 0, DO_PML = 96 * MiB;

constexpr int CW_BAR = 4096;
constexpr int CW_MOBACNT = 16384;
constexpr int CW_MOECNT = 20480;

constexpr int RING_BYTES = 131072;
constexpr int LDSCTL_OFF = RING_BYTES;
constexpr int LDS_X_OFF = RING_BYTES + 256;
constexpr int LDS_BYTES = 163840;

#define XB_TMO      128
#define XB_XCNT(j)  (256  + 64 * (j))
#define XB_XSUB(j)  (1280 + 64 * (j))
#define XB_XGEN(j)  (2304 + 64 * (j))
#define XB_TOP      3328
#define XB_TOPGEN   3392
#define XCD_BAR_WORDS 3456
#define XB_SPIN_CAP (1u << 18)
__device__ __forceinline__ unsigned xb_ld(unsigned* p)              { return __hip_atomic_load(p, __ATOMIC_RELAXED, __HIP_MEMORY_SCOPE_AGENT); }
__device__ __forceinline__ unsigned xb_add(unsigned* p, unsigned v) { return __hip_atomic_fetch_add(p, v, __ATOMIC_RELAXED, __HIP_MEMORY_SCOPE_AGENT); }
__device__ __forceinline__ unsigned xb_xcc_id() { return (unsigned)__builtin_amdgcn_s_getreg((3 << 11) | 20) & 0xFu; }
#define XB_SPIN(cond, bar) do { unsigned _sp = 0; while (cond) { __builtin_amdgcn_s_sleep(1); \
    if ((++_sp & 255u) == 0u) { if (xb_ld(&(bar)[XB_TMO])) break; if (_sp > XB_SPIN_CAP) { atomicAdd(&(bar)[XB_TMO], 1u); break; } } } } while (0)
struct XcdBarrier { unsigned* bar; unsigned x; volatile LAS unsigned* st; };
__device__ __forceinline__ XcdBarrier xcd_barrier_post(unsigned* bar, volatile LAS unsigned* st) {
    XcdBarrier b; b.bar = bar; b.x = xb_xcc_id(); b.st = st;
    if (threadIdx.x == 0) (void)xb_add(&bar[XB_XCNT(b.x)], 1u);
    return b;
}
__device__ __forceinline__ void xcd_barrier_complete(unsigned* bar, unsigned x, unsigned& nloc, unsigned& nx) {
    const unsigned G = gridDim.x * gridDim.y * gridDim.z;
    unsigned sum, cnt, mine, sp = 0u;
    for (;;) {
        sum = 0u; cnt = 0u; mine = 0u;
#pragma unroll
        for (unsigned j = 0; j < 16; ++j) { const unsigned c = xb_ld(&bar[XB_XCNT(j)]); sum += c; cnt += (c > 0u) ? 1u : 0u; mine = (j == x) ? c : mine; }
        if (sum == G) break;
        __builtin_amdgcn_s_sleep(1);
        if ((++sp & 255u) == 0u) { if (xb_ld(&bar[XB_TMO])) break; if (sp > XB_SPIN_CAP) { atomicAdd(&bar[XB_TMO], 1u); break; } }
    }
    nloc = mine > 0u ? mine : 1u; nx = cnt > 0u ? cnt : 1u;
}
__device__ __forceinline__ void xcd_barrier(const XcdBarrier& b) {
    asm volatile("s_waitcnt vmcnt(0)" ::: "memory");
    __syncthreads();
    if (threadIdx.x == 0) {
        unsigned* bar = b.bar; unsigned bx = b.x; asm volatile("" : "+s"(bar), "+s"(bx));
        __builtin_amdgcn_s_waitcnt(0);
        unsigned nloc = b.st[0], nx = b.st[1];
        if (nloc == 0u) { xcd_barrier_complete(bar, bx, nloc, nx); b.st[0] = nloc; b.st[1] = nx; }
        const unsigned old = xb_add(&bar[XB_XSUB(bx)], 1u);
        const unsigned gen = old / nloc;
        if (old + 1u == (gen + 1u) * nloc) {
            __builtin_amdgcn_fence(__ATOMIC_RELEASE, "agent");
            asm volatile("s_waitcnt vmcnt(0)" ::: "memory");
            const unsigned og = xb_add(&bar[XB_TOP], 1u);
            const unsigned tg = og / nx;
            if (og + 1u == (tg + 1u) * nx) xb_add(&bar[XB_TOPGEN], 1u);
            else XB_SPIN(xb_ld(&bar[XB_TOPGEN]) == tg, bar);
            __builtin_amdgcn_fence(__ATOMIC_ACQUIRE, "agent");
            xb_add(&bar[XB_XGEN(bx)], 1u);
            asm volatile("s_waitcnt vmcnt(0)" ::: "memory");
        } else {
            XB_SPIN(xb_ld(&bar[XB_XGEN(bx)]) == gen, bar);
            __builtin_amdgcn_fence(__ATOMIC_ACQUIRE, "agent");
            asm volatile("s_waitcnt vmcnt(0)" ::: "memory");
        }
    }
    __syncthreads();
}

struct Args { const float* in[27]; float* out; unsigned char* ws; int ph_lo, ph_hi; };
enum InIdx { I_X = 0, I_P, I_RELB, I_EWIN, I_GLAWG, I_GLABG, I_GLAN, I_EWOUT, I_OWIN, I_HGAMMA, I_HNORM, I_RNORM, I_OWOUT, I_LMG, I_LMB, I_LFG, I_LFB,
             I_FW1, I_FW3, I_FW2, I_RW, I_RB, I_XW1, I_XW3, I_XW2, I_PWG, I_PWP };
struct Frame {
    LAS unsigned char* lds; int tid, lane, wave, vcu, G; unsigned char* ws; gu32* ctl; const Args* a;
};
__device__ __forceinline__ void launder(Frame& F) {
    int t = threadIdx.x; asm volatile("" : "+v"(t)); F.tid = t; F.lane = t & 63; F.wave = __builtin_amdgcn_readfirstlane(t >> 6);
    unsigned char* w = F.ws; asm volatile("" : "+s"(w)); F.ws = w; F.ctl = (gu32*)(w + WS_CTL);
    int v = F.vcu, g = F.G; asm volatile("" : "+s"(v), "+s"(g)); F.vcu = v; F.G = g;
}
__device__ __forceinline__ float wave_sum(float v) {
#pragma unroll
    for (int o = 1; o < 64; o <<= 1) v += __shfl_xor(v, o);
    return v;
}

__device__ __forceinline__ int rowmap(int mode, int n) {
    if (mode == 0) return n;
    if (mode == 1) return n < 2560 ? n : (n < 2576 ? 3072 + (n - 2560) : 2560 + (n - 2576));
    if (mode == 2) return (n >> 7) * 256 + (n & 127);
    return (n >> 7) * 256 + 128 + (n & 127);
}
__device__ __forceinline__ void transpose_item(const float* W, int N, h16* WT, int ldk, int mode, LAS float* scr, int item, int lane) {
    const int nblk = (N + 31) / 32, kb = item / nblk, nb = item % nblk, k0 = 64 * kb, n0 = 32 * nb;
    const int nn = n0 + (lane & 31); const bool ok = nn < N;
#pragma unroll 8
    for (int i = 0; i < 32; ++i) { const int kk = 2 * i + (lane >> 5); scr[kk * 33 + (lane & 31)] = ok ? W[(size_t)(k0 + kk) * N + nn] : 0.f; }
    LDS_WAIT(); asm volatile("" ::: "memory");
    const int c = lane & 7;
#pragma unroll
    for (int j = 0; j < 4; ++j) { const int n = (lane >> 3) + 8 * j; const LAS float* s = scr + (8 * c) * 33 + n;
        if (n0 + n < N) { h16x8 o;
#pragma unroll
            for (int q = 0; q < 8; ++q) o[q] = (h16)s[q * 33];
            *(h16x8*)(WT + (size_t)rowmap(mode, n0 + n) * ldk + k0 + 8 * c) = o; } }
    LDS_WAIT(); asm volatile("" ::: "memory");
}
struct TDesc { const float* W; int K, N; h16* WT; int ldk, mode; };
__device__ __forceinline__ int titems(const TDesc& d) { return (d.K / 64) * ((d.N + 31) / 32); }

__device__ __forceinline__ void zero16(void* p) { *(u32x4*)p = (u32x4){0u, 0u, 0u, 0u}; }
__device__ __forceinline__ void cvt8(const float* src, h16* dst) { const f32x4 a = *(const f32x4*)src, b = *(const f32x4*)(src + 4); *(h16x8*)dst = pg8::pack8(a, b); }
__device__ __forceinline__ int t5_bucket(int n) {
    if (n < 16) return n < 0 ? 0 : n;
    int b = 16;
    b += (n >= 19) + (n >= 21) + (n >= 24) + (n >= 27) + (n >= 31) + (n >= 35) + (n >= 40) + (n >= 46) + (n >= 52) + (n >= 59) + (n >= 67) + (n >= 77) + (n >= 87) + (n >= 99) + (n >= 113);
    return b;
}
__device__ __forceinline__ void p_prologue(Frame& F) {
    const Args& A = *F.a; unsigned char* ws = F.ws;
    LAS float* scr = (LAS float*)(F.lds + F.wave * 16384);
    const int gw = F.vcu * NWAVES + F.wave, NGW = F.G * NWAVES;
    constexpr int T0 = 16 * 97, T1 = 16 * 32, T2 = 16 * 86, T3 = T2, T4 = 43 * 32, T5 = 16 * 32, T6 = T5, T7 = 4 * 32, T8 = T7, T9 = 16 * 96, T10 = 16 * 32;
    constexpr int NT = T0 + T1 + T2 + T3 + T4 + T5 + T6 + T7 + T8 + T9 + T10;
    for (int it = gw; it < NT; it += NGW) {
        int r = it;
        if (r < T0) { transpose_item(A.in[I_EWIN], 3088, (h16*)(ws + WS_WIN0), 1024, 1, scr, r, F.lane); continue; } r -= T0;
        if (r < T1) { transpose_item(A.in[I_EWOUT], 1024, (h16*)(ws + WS_WOUT0), 1024, 0, scr, r, F.lane); continue; } r -= T1;
        if (r < T2) { transpose_item(A.in[I_FW1], FD, (h16*)(ws + WS_W13_0), 1024, 2, scr, r, F.lane); continue; } r -= T2;
        if (r < T3) { transpose_item(A.in[I_FW3], FD, (h16*)(ws + WS_W13_0), 1024, 3, scr, r, F.lane); continue; } r -= T3;
        if (r < T4) { transpose_item(A.in[I_FW2], 1024, (h16*)(ws + WS_W2_0), FDP, 0, scr, r, F.lane); continue; } r -= T4;
        if (r < T5) { transpose_item(A.in[I_PWG], 1024, (h16*)(ws + WS_WG0), 1024, 0, scr, r, F.lane); continue; } r -= T5;
        if (r < T6) { transpose_item(A.in[I_PWG] + 1024 * 1024, 1024, (h16*)(ws + WS_WG1), 1024, 0, scr, r, F.lane); continue; } r -= T6;
        if (r < T7) { transpose_item(A.in[I_PWP], 1024, (h16*)(ws + WS_WP0), 256, 0, scr, r, F.lane); continue; } r -= T7;
        if (r < T8) { transpose_item(A.in[I_PWP] + 256 * 1024, 1024, (h16*)(ws + WS_WP1), 256, 0, scr, r, F.lane); continue; } r -= T8;
        if (r < T9) { transpose_item(A.in[I_OWIN], N1, (h16*)(ws + WS_WIN1), 1024, 0, scr, r, F.lane); continue; } r -= T9;
        transpose_item(A.in[I_OWOUT], 1024, (h16*)(ws + WS_WOUT1), 1024, 0, scr, r, F.lane);
    }
    const size_t gt = (size_t)F.vcu * NTHR + F.tid, NGT = (size_t)F.G * NTHR;
    { h16* w = (h16*)(ws + WS_WIN0) + (size_t)3088 * 1024; for (size_t i = gt; i < 30720; i += NGT) zero16(w + i * 8); }
    { h16* w = (h16*)(ws + WS_W13_0); for (size_t i = gt; i < 128 * 128; i += NGT) { const int rr = (int)(i >> 7), ch = (int)(i & 127); const int row = 21 * 256 + (rr < 64 ? 64 + rr : 128 + 64 + (rr - 64)); zero16(w + (size_t)row * 1024 + ch * 8); } }
    { h16* w = (h16*)(ws + WS_W2_0); for (size_t i = gt; i < 1024 * 8; i += NGT) { const int row = (int)(i >> 3), ch = (int)(i & 7); zero16(w + (size_t)row * FDP + FD + ch * 8); } }
    { const float* x = A.in[I_X]; h16* xa = (h16*)(ws + WS_XA); for (size_t i = gt; i < (size_t)M * DM / 8; i += NGT) cvt8(x + i * 8, xa + i * 8); }
    { const float* p = A.in[I_P]; h16* ph = (h16*)(ws + WS_PH); for (size_t i = gt; i < (size_t)2 * M * PLE / 8; i += NGT) cvt8(p + i * 8, ph + i * 8); }
    { float* rc = (float*)(ws + WS_ROPE); float* rs = rc + SEQ * 32;
      for (size_t i = gt; i < (size_t)SEQ * 32; i += NGT) { const int t = (int)(i >> 5), k = (int)(i & 31); const float inv = (float)pow(10000.0, -(double)k / 32.0); const float ang = (float)t * inv;
          rc[i] = (float)cos((double)ang); rs[i] = (float)sin((double)ang); } }
    { float* bl = (float*)(ws + WS_BIASL); const float* rb = A.in[I_RELB]; for (size_t i = gt; i < 8 * 128; i += NGT) { const int h = (int)(i >> 7), d = (int)(i & 127); bl[i] = rb[t5_bucket(d) * 8 + h]; } }
}

template <int MODE>
__device__ __forceinline__ void ln_phase(Frame& F, const h16* Y, const float* gam, const float* bet, h16* Xout, const h16* XR, const h16* ys) {
    const Args& A = *F.a;
    LAS float* wr_l = (LAS float*)F.lds;
    LAS int* rt_l = (LAS int*)(F.lds + 32768);
    LAS float* rg_l = (LAS float*)(F.lds + 32768 + 2048);
    LAS int* lcnt = (LAS int*)(F.lds + 32768 + 4096);
    int* route = (int*)(F.ws + WS_ROUTE);
    if (MODE == 1) { const float* rw = A.in[I_RW]; for (int i = F.tid; i < 8192; i += NTHR) wr_l[i] = rw[i]; }
    f32x4 g4[4], b4[4];
#pragma unroll
    for (int j = 0; j < 2; ++j) { const int c = j * 512 + F.lane * 8; g4[2 * j] = *(const f32x4*)(gam + c); g4[2 * j + 1] = *(const f32x4*)(gam + c + 4); b4[2 * j] = *(const f32x4*)(bet + c); b4[2 * j + 1] = *(const f32x4*)(bet + c + 4); }
    for (int rb = F.vcu * 128; rb < M; rb += F.G * 128) {
        if (MODE == 1) { if (F.tid < 16) lcnt[F.tid] = 0; __syncthreads(); }
        for (int i = 0; i < 16; ++i) {
            const int row = rb + F.wave * 16 + i;
            float v[16];
            if (MODE == 2) {
                const int* rr = route + (size_t)row * 8; const float g0 = __int_as_float(rr[4]), g1 = __int_as_float(rr[5]);
#pragma unroll
                for (int j = 0; j < 2; ++j) { const int c = j * 512 + F.lane * 8; const h16x8 xr = *(const h16x8*)(XR + (size_t)row * DM + c), y0 = *(const h16x8*)(ys + (size_t)(2 * row) * DM + c), y1 = *(const h16x8*)(ys + (size_t)(2 * row + 1) * DM + c);
#pragma unroll
                    for (int q = 0; q < 8; ++q) v[8 * j + q] = DN_ALPHA * (float)xr[q] + g0 * (float)y0[q] + g1 * (float)y1[q]; }
            } else {
#pragma unroll
                for (int j = 0; j < 2; ++j) { const h16x8 y = *(const h16x8*)(Y + (size_t)row * DM + j * 512 + F.lane * 8);
#pragma unroll
                    for (int q = 0; q < 8; ++q) v[8 * j + q] = (float)y[q]; }
            }
            float s = 0.f;
#pragma unroll
            for (int q = 0; q < 16; ++q) s += v[q];
            const float mean = wave_sum(s) * (1.f / DM); float s2 = 0.f;
#pragma unroll
            for (int q = 0; q < 16; ++q) { v[q] -= mean; s2 += v[q] * v[q]; }
            const float rstd = 1.f / sqrtf(wave_sum(s2) * (1.f / DM) + LN_EPS);
#pragma unroll
            for (int q = 0; q < 16; ++q) v[q] = v[q] * rstd * g4[q >> 2][q & 3] + b4[q >> 2][q & 3];
#pragma unroll
            for (int j = 0; j < 2; ++j) { h16x8 o;
#pragma unroll
                for (int q = 0; q < 8; ++q) o[q] = (h16)v[8 * j + q];
                *(h16x8*)(Xout + (size_t)row * DM + j * 512 + F.lane * 8) = o; }
            if (MODE == 1) {
                float lg[8];
#pragma unroll
                for (int e = 0; e < 8; ++e) lg[e] = 0.f;
#pragma unroll
                for (int j = 0; j < 2; ++j)
#pragma unroll
                    for (int q = 0; q < 8; ++q) { const int c = j * 512 + F.lane * 8 + q; const f32x4 w0 = *(const LAS f32x4*)(wr_l + c * 8), w1 = *(const LAS f32x4*)(wr_l + c * 8 + 4); const float x = v[8 * j + q];
                        lg[0] += x * w0[0]; lg[1] += x * w0[1]; lg[2] += x * w0[2]; lg[3] += x * w0[3]; lg[4] += x * w1[0]; lg[5] += x * w1[1]; lg[6] += x * w1[2]; lg[7] += x * w1[3]; }
#pragma unroll
                for (int e = 0; e < 8; ++e) lg[e] = wave_sum(lg[e]) + A.in[I_RB][e];
                if (F.lane == 0) {
                    int e0 = 0; float m0 = lg[0];
#pragma unroll
                    for (int e = 1; e < 8; ++e) if (lg[e] > m0) { m0 = lg[e]; e0 = e; }
                    int e1 = -1; float m1 = -INFINITY;
#pragma unroll
                    for (int e = 0; e < 8; ++e) if (e != e0 && lg[e] > m1) { m1 = lg[e]; e1 = e; }
                    const float g0 = 1.f / (1.f + expf(m1 - m0));
                    const int s0 = atomicAdd((int*)&lcnt[e0], 1), s1 = atomicAdd((int*)&lcnt[e1], 1);
                    const int li = F.wave * 16 + i;
                    rt_l[li * 4 + 0] = e0; rt_l[li * 4 + 1] = s0; rt_l[li * 4 + 2] = e1; rt_l[li * 4 + 3] = s1; rg_l[li * 2] = g0; rg_l[li * 2 + 1] = 1.f - g0;
                }
            }
        }
        if (MODE == 1) {
            __syncthreads();
            if (F.tid < 8) lcnt[8 + F.tid] = (int)__hip_atomic_fetch_add(F.ctl + CW_MOECNT + F.tid, (unsigned)lcnt[F.tid], RLX_AGENT);
            __syncthreads();
            if (F.tid < 128) { const int row = rb + F.tid; int* rr = route + (size_t)row * 8; const int e0 = rt_l[F.tid * 4], e1 = rt_l[F.tid * 4 + 2];
                rr[0] = e0; rr[1] = lcnt[8 + e0] + rt_l[F.tid * 4 + 1]; rr[2] = e1; rr[3] = lcnt[8 + e1] + rt_l[F.tid * 4 + 3]; rr[4] = __float_as_int(rg_l[F.tid * 2]); rr[5] = __float_as_int(rg_l[F.tid * 2 + 1]); }
            __syncthreads();
        }
    }
}

constexpr int KL_STRIDE = 72, VT_STRIDE = 264;
constexpr int LIST_PER_BH = 516096;
__device__ __forceinline__ int moba_binoff(int j) { return 256 * (63 * j - (j * (j - 1)) / 2); }

__device__ __forceinline__ void moba_kmean_unit(Frame& F, int u) {
    const int b = u >> 6, blk = u & 63; const h16* Hh = (const h16*)(F.ws + WS_H);
    const h16* p = Hh + (size_t)(b * SEQ + blk * 256) * N0 + C0_MK + F.tid;
    float s = 0.f;
#pragma unroll 8
    for (int r = 0; r < 256; ++r) s += (float)p[(size_t)r * N0];
    float* km = (float*)(F.ws + WS_KMEAN);
    km[((size_t)(b * 8 + (F.tid >> 6)) * 64 + blk) * 64 + (F.tid & 63)] = s * (1.f / 256.f);
}

__device__ __forceinline__ bool better(float av, int ai, float bv, int bi) { return av > bv || (av == bv && ai < bi); }
__device__ __forceinline__ void top3_insert(float g, int n, float& v0, int& i0, float& v1, int& i1, float& v2, int& i2) {
    const bool b2 = better(g, n, v2, i2), b1 = better(g, n, v1, i1), b0 = better(g, n, v0, i0);
    const float nv2 = b1 ? v1 : (b2 ? g : v2); const int ni2 = b1 ? i1 : (b2 ? n : i2);
    const float nv1 = b0 ? v0 : (b1 ? g : v1); const int ni1 = b0 ? i0 : (b1 ? n : i1);
    const float nv0 = b0 ? g : v0; const int ni0 = b0 ? n : i0;
    v0 = nv0; i0 = ni0; v1 = nv1; i1 = ni1; v2 = nv2; i2 = ni2;
}
__device__ __forceinline__ void moba_select_unit(Frame& F, int u) {
    const int bh = u / 63, c = 1 + u % 63, b = bh >> 3, h = bh & 7;
    LAS float* km = (LAS float*)F.lds; LAS int* hist = (LAS int*)(F.lds + 16384); LAS int* gbase = hist + 64;
    const float* kmg = (const float*)(F.ws + WS_KMEAN) + (size_t)bh * 64 * 64;
    __syncthreads();
    for (int i = F.tid; i < c * 64; i += NTHR) km[i] = kmg[i];
    if (F.tid < 64) hist[F.tid] = 0;
    const int q = F.tid >> 1, half = F.tid & 1;
    const h16* Hh = (const h16*)(F.ws + WS_H);
    const h16* qp = Hh + (size_t)(b * SEQ + c * 256 + q) * N0 + C0_MQ + h * 64;
    float qv[64];
#pragma unroll
    for (int j = 0; j < 8; ++j) { const h16x8 t = *(const h16x8*)(qp + 8 * j);
#pragma unroll
        for (int k = 0; k < 8; ++k) qv[8 * j + k] = (float)t[k]; }
    __syncthreads();
    float v0 = -INFINITY, v1 = -INFINITY, v2 = -INFINITY; int i0 = 1000, i1 = 1001, i2 = 1002;
    for (int n = half; n < c; n += 2) {
        const LAS f32x4* kr = (const LAS f32x4*)(km + n * 64); float g = 0.f;
#pragma unroll
        for (int j = 0; j < 16; ++j) { const f32x4 kk = kr[j]; g += qv[4 * j] * kk[0] + qv[4 * j + 1] * kk[1] + qv[4 * j + 2] * kk[2] + qv[4 * j + 3] * kk[3]; }
        top3_insert(g, n, v0, i0, v1, i1, v2, i2);
    }
    { const float pv0 = __shfl_xor(v0, 1), pv1 = __shfl_xor(v1, 1), pv2 = __shfl_xor(v2, 1); const int pi0 = __shfl_xor(i0, 1), pi1 = __shfl_xor(i1, 1), pi2 = __shfl_xor(i2, 1);
      top3_insert(pv0, pi0, v0, i0, v1, i1, v2, i2); top3_insert(pv1, pi1, v0, i0, v1, i1, v2, i2); top3_insert(pv2, pi2, v0, i0, v1, i1, v2, i2); }
    const int nvalid = c < 3 ? c : 3;
    int pos0 = 0, pos1 = 0, pos2 = 0;
    if (half == 0) { pos0 = atomicAdd((int*)&hist[i0], 1); if (nvalid > 1) pos1 = atomicAdd((int*)&hist[i1], 1); if (nvalid > 2) pos2 = atomicAdd((int*)&hist[i2], 1); }
    __syncthreads();
    if (F.tid < c) { const int n = hist[F.tid]; gbase[F.tid] = n ? (int)__hip_atomic_fetch_add(F.ctl + CW_MOBACNT + bh * 64 + F.tid, (unsigned)n, RLX_AGENT) : 0; }
    __syncthreads();
    if (half == 0) {
        unsigned short* list = (unsigned short*)(F.ws + WS_LIST) + (size_t)bh * LIST_PER_BH; const int t = c * 256 + q;
        list[moba_binoff(i0) + gbase[i0] + pos0] = (unsigned short)(t | (0 << 14));
        if (nvalid > 1) list[moba_binoff(i1) + gbase[i1] + pos1] = (unsigned short)(t | (1 << 14));
        if (nvalid > 2) list[moba_binoff(i2) + gbase[i2] + pos2] = (unsigned short)(t | (2 << 14));
    }
}

__device__ __forceinline__ void moba_stage(Frame& F, int b, int h, int j, LAS h16* K_l, LAS h16* VT_l, LAS float* BL_l) {
    const h16* Hh = (const h16*)(F.ws + WS_H);
    const h16* kb = Hh + (size_t)(b * SEQ + j * 256) * N0 + C0_MK + h * 64;
    const h16* vb = Hh + (size_t)(b * SEQ + j * 256) * N0 + C0_MV + h * 64;
#pragma unroll
    for (int i = 0; i < 4; ++i) { const int id = F.tid + i * NTHR, r = id >> 3, ch = id & 7;
        const h16x8 kv = *(const h16x8*)(kb + (size_t)r * N0 + ch * 8); *(LAS h16x8*)(K_l + r * KL_STRIDE + ch * 8) = kv;
        const h16x8 vv = *(const h16x8*)(vb + (size_t)r * N0 + ch * 8);
#pragma unroll
        for (int k = 0; k < 8; ++k) VT_l[(ch * 8 + k) * VT_STRIDE + r] = vv[k]; }
    if (F.tid < 128) BL_l[F.tid] = ((const float*)(F.ws + WS_BIASL))[h * 128 + F.tid];
}

__device__ __forceinline__ void block_scan_1024(Frame& F, int a, int b, LAS int* out, LAS int* wsum) {
    int s = a + b, inc = s;
#pragma unroll
    for (int o = 1; o < 64; o <<= 1) { const int t = __shfl_up(inc, o); if (F.lane >= o) inc += t; }
    if (F.lane == 63) wsum[F.wave] = inc;
    __syncthreads();
    int base = 0;
    for (int w = 0; w < F.wave; ++w) base += wsum[w];
    const int ex = base + inc - s;
    out[2 * F.tid] = ex; out[2 * F.tid + 1] = ex + a;
    if (F.tid == NTHR - 1) out[1024] = ex + s;
    __syncthreads();
}

__device__ __forceinline__ void moba_sparse_phase(Frame& F) {
    LAS h16* K_l = (LAS h16*)F.lds; LAS h16* VT_l = (LAS h16*)(F.lds + 36864); LAS float* BL_l = (LAS float*)(F.lds + 70656);
    LAS int* pfx = (LAS int*)(F.lds + 71680); LAS int* wsum = (LAS int*)(F.lds + 71680 + 4224);
    const gu32* cnts = F.ctl + CW_MOBACNT;
    int pa, pb; { const int b0 = 2 * F.tid, b1 = b0 + 1;
        pa = b0 < 1008 ? (int)((__hip_atomic_load(cnts + (b0 / 63) * 64 + b0 % 63, RLX_AGENT) + 511u) >> 9) : 0;
        pb = b1 < 1008 ? (int)((__hip_atomic_load(cnts + (b1 / 63) * 64 + b1 % 63, RLX_AGENT) + 511u) >> 9) : 0; }
    __syncthreads();
    block_scan_1024(F, pa, pb, pfx, wsum);
    const int NI = pfx[1008];
    const int k0 = (int)((long)F.vcu * NI / F.G), k1 = (int)((long)(F.vcu + 1) * NI / F.G);
    const h16* Hh = (const h16*)(F.ws + WS_H);
    h16* PO = (h16*)((unsigned char*)F.a->out + DO_PO); float* PML = (float*)((unsigned char*)F.a->out + DO_PML);
    int pbin = -1;
    const int q = F.lane & 15, fq = F.lane >> 4;
    for (int k = k0; k < k1; ++k) {
        int lo = 0, hi = 1007;
        while (lo < hi) { const int mid = (lo + hi + 1) >> 1; if (pfx[mid] <= k) lo = mid; else hi = mid - 1; }
        const int bin = lo, part = k - pfx[bin], bh = bin / 63, j = bin % 63, b = bh >> 3, h = bh & 7;
        if (bin != pbin) { __syncthreads(); moba_stage(F, b, h, j, K_l, VT_l, BL_l); pbin = bin; __syncthreads(); }
        const int cnt = (int)__hip_atomic_load(cnts + bh * 64 + j, RLX_AGENT);
        const unsigned short* list = (const unsigned short*)(F.ws + WS_LIST) + (size_t)bh * LIST_PER_BH + moba_binoff(j);
        const int nq = (cnt - part * 512) < 512 ? (cnt - part * 512) : 512, ntile = (nq + 15) >> 4;
        for (int tile = F.wave; tile < ntile; tile += NWAVES) {
            const int idx = part * 512 + tile * 16 + q; const bool valid = idx < cnt;
            const int entry = valid ? (int)list[idx] : ((j + 1) * 256);
            const int tq = entry & 0x3fff;
            const h16* qp = Hh + (size_t)(b * SEQ + tq) * N0 + C0_MQ + h * 64 + 8 * fq;
            const h16x8 qf0 = *(const h16x8*)qp, qf1 = *(const h16x8*)(qp + 32);
            f32x4 s[16];
#pragma unroll
            for (int kt = 0; kt < 16; ++kt) { const LAS h16* kp = K_l + (16 * kt + q) * KL_STRIDE + 8 * fq;
                f32x4 a = (f32x4){0.f, 0.f, 0.f, 0.f};
                a = __builtin_amdgcn_mfma_f32_16x16x32_f16(*(const LAS h16x8*)kp, qf0, a, 0, 0, 0);
                a = __builtin_amdgcn_mfma_f32_16x16x32_f16(*(const LAS h16x8*)(kp + 32), qf1, a, 0, 0, 0); s[kt] = a;
                if ((kt & 3) == 3) __builtin_amdgcn_sched_barrier(0); }
            const int dmin = tq - (256 * j + 255);
            float mx = -INFINITY;
            if (__all(dmin >= 113)) { const float bc = BL_l[127];
#pragma unroll
                for (int kt = 0; kt < 16; ++kt)
#pragma unroll
                    for (int r = 0; r < 4; ++r) { s[kt][r] = s[kt][r] * 0.125f + bc; mx = fmaxf(mx, s[kt][r]); }
            } else {
#pragma unroll
                for (int kt = 0; kt < 16; ++kt)
#pragma unroll
                    for (int r = 0; r < 4; ++r) { int d = tq - (256 * j + 16 * kt + 4 * fq + r); d = d > 127 ? 127 : (d < 0 ? 0 : d); s[kt][r] = s[kt][r] * 0.125f + BL_l[d]; mx = fmaxf(mx, s[kt][r]); }
            }
            mx = fmaxf(mx, __shfl_xor(mx, 16)); mx = fmaxf(mx, __shfl_xor(mx, 32));
            float l = 0.f; h16x8 pf[8];
#pragma unroll
            for (int ks = 0; ks < 8; ++ks) {
#pragma unroll
                for (int r = 0; r < 4; ++r) { const float p0 = __expf(s[2 * ks][r] - mx), p1 = __expf(s[2 * ks + 1][r] - mx); l += p0 + p1; pf[ks][r] = (h16)p0; pf[ks][4 + r] = (h16)p1; } }
            l += __shfl_xor(l, 16); l += __shfl_xor(l, 32);
            f32x4 o[4];
#pragma unroll
            for (int dt = 0; dt < 4; ++dt) { o[dt] = (f32x4){0.f, 0.f, 0.f, 0.f}; const LAS h16* vp = VT_l + (16 * dt + q) * VT_STRIDE + 4 * fq;
#pragma unroll
                for (int ks = 0; ks < 8; ++ks) { const h16x4 lo4 = *(const LAS h16x4*)(vp + 32 * ks), hi4 = *(const LAS h16x4*)(vp + 32 * ks + 16);
                    h16x8 vf; vf[0] = lo4[0]; vf[1] = lo4[1]; vf[2] = lo4[2]; vf[3] = lo4[3]; vf[4] = hi4[0]; vf[5] = hi4[1]; vf[6] = hi4[2]; vf[7] = hi4[3];
                    o[dt] = __builtin_amdgcn_mfma_f32_16x16x32_f16(pf[ks], vf, o[dt], 0, 0, 0); } }
            const int ev = valid ? entry : -1;
#pragma unroll
            for (int r = 0; r < 4; ++r) { const int e2 = __shfl(ev, 4 * fq + r);
                if (e2 >= 0) { const size_t base = (((size_t)(b * SEQ + (e2 & 0x3fff)) * 8 + h) * 3 + (e2 >> 14)) * 64 + q;
#pragma unroll
                    for (int dt = 0; dt < 4; ++dt) PO[base + 16 * dt] = (h16)o[dt][r]; } }
            if (fq == 0 && valid) { const size_t mi = (((size_t)(b * SEQ + tq) * 8 + h) * 3 + (entry >> 14)) * 2; *(f32x2*)(PML + mi) = (f32x2){mx, l}; }
        }
    }
}

__device__ __forceinline__ void moba_own_unit(Frame& F, int u) {
    const int bh = u >> 6, c = u & 63, b = bh >> 3, h = bh & 7;
    LAS h16* K_l = (LAS h16*)F.lds; LAS h16* VT_l = (LAS h16*)(F.lds + 36864); LAS float* BL_l = (LAS float*)(F.lds + 70656);
    __syncthreads(); moba_stage(F, b, h, c, K_l, VT_l, BL_l); __syncthreads();
    const h16* Hh = (const h16*)(F.ws + WS_H);
    const h16* PO = (const h16*)((unsigned char*)F.a->out + DO_PO); const float* PML = (const float*)((unsigned char*)F.a->out + DO_PML);
    h16* MX = (h16*)(F.ws + WS_MIXIN0);
    const int q = F.lane & 15, fq = F.lane >> 4; const int nvalid = c < 3 ? c : 3;
#pragma unroll 1
    for (int s2 = 0; s2 < 2; ++s2) {
        const int ti = s2 == 0 ? F.wave : 15 - F.wave;
        const int tl = 16 * ti + q; const size_t row = (size_t)b * SEQ + c * 256 + tl;
        const h16* qp = Hh + row * N0 + C0_MQ + h * 64 + 8 * fq;
        const h16x8 qf0 = *(const h16x8*)qp, qf1 = *(const h16x8*)(qp + 32);
        f32x4 s[16]; float mx = -INFINITY;
#pragma unroll
        for (int kt = 0; kt < 16; ++kt) {
            if (kt <= ti) { const LAS h16* kp = K_l + (16 * kt + q) * KL_STRIDE + 8 * fq;
                f32x4 a = (f32x4){0.f, 0.f, 0.f, 0.f};
                a = __builtin_amdgcn_mfma_f32_16x16x32_f16(*(const LAS h16x8*)kp, qf0, a, 0, 0, 0);
                a = __builtin_amdgcn_mfma_f32_16x16x32_f16(*(const LAS h16x8*)(kp + 32), qf1, a, 0, 0, 0);
#pragma unroll
                for (int r = 0; r < 4; ++r) { const int d = tl - (16 * kt + 4 * fq + r); const float v = a[r] * 0.125f + BL_l[d > 127 ? 127 : (d < 0 ? 0 : d)]; a[r] = d >= 0 ? v : -INFINITY; mx = fmaxf(mx, a[r]); }
                s[kt] = a;
            } else s[kt] = (f32x4){-INFINITY, -INFINITY, -INFINITY, -INFINITY};
            if ((kt & 3) == 3) __builtin_amdgcn_sched_barrier(0);
        }
        mx = fmaxf(mx, __shfl_xor(mx, 16)); mx = fmaxf(mx, __shfl_xor(mx, 32));
        float l = 0.f; h16x8 pf[8];
#pragma unroll
        for (int ks = 0; ks < 8; ++ks) {
#pragma unroll
            for (int r = 0; r < 4; ++r) { const float p0 = __expf(s[2 * ks][r] - mx), p1 = __expf(s[2 * ks + 1][r] - mx); l += p0 + p1; pf[ks][r] = (h16)p0; pf[ks][4 + r] = (h16)p1; } }
        l += __shfl_xor(l, 16); l += __shfl_xor(l, 32);
        f32x4 o[4];
#pragma unroll
        for (int dt = 0; dt < 4; ++dt) { o[dt] = (f32x4){0.f, 0.f, 0.f, 0.f}; const LAS h16* vp = VT_l + (16 * dt + q) * VT_STRIDE + 4 * fq;
#pragma unroll
            for (int ks = 0; ks < 8; ++ks) { if (2 * ks <= ti) { const h16x4 lo4 = *(const LAS h16x4*)(vp + 32 * ks), hi4 = *(const LAS h16x4*)(vp + 32 * ks + 16);
                h16x8 vf; vf[0] = lo4[0]; vf[1] = lo4[1]; vf[2] = lo4[2]; vf[3] = lo4[3]; vf[4] = hi4[0]; vf[5] = hi4[1]; vf[6] = hi4[2]; vf[7] = hi4[3];
                o[dt] = __builtin_amdgcn_mfma_f32_16x16x32_f16(pf[ks], vf, o[dt], 0, 0, 0); } } }
        float mr[3], lr[3]; float Mx = mx;
#pragma unroll
        for (int k = 0; k < 3; ++k) { if (k < nvalid) { const f32x2 t = *(const f32x2*)(PML + ((row * 8 + h) * 3 + k) * 2); mr[k] = t[0]; lr[k] = t[1]; Mx = fmaxf(Mx, mr[k]); } else { mr[k] = -INFINITY; lr[k] = 0.f; } }
        const float wo = __expf(mx - Mx); float den = l * wo; float wk[3];
#pragma unroll
        for (int k = 0; k < 3; ++k) { wk[k] = k < nvalid ? __expf(mr[k] - Mx) : 0.f; den += lr[k] * wk[k]; }
        const float inv = 1.f / den;
#pragma unroll
        for (int r = 0; r < 4; ++r) { const int q2 = 4 * fq + r; const float wo2 = __shfl(wo, q2) , inv2 = __shfl(inv, q2); const float w0 = __shfl(wk[0], q2), w1 = __shfl(wk[1], q2), w2 = __shfl(wk[2], q2);
            const size_t row2 = (size_t)b * SEQ + c * 256 + 16 * ti + q2; const h16* pp = PO + ((row2 * 8 + h) * 3) * 64 + q;
#pragma unroll
            for (int dt = 0; dt < 4; ++dt) { float v = o[dt][r] * wo2;
                if (nvalid > 0) v += (float)pp[16 * dt] * w0;
                if (nvalid > 1) v += (float)pp[64 + 16 * dt] * w1;
                if (nvalid > 2) v += (float)pp[128 + 16 * dt] * w2;
                MX[row2 * DM + h * 64 + 16 * dt + q] = (h16)(v * inv2); }
            asm volatile("" ::: "memory"); }
    }
}

constexpr int GS = 72;
template <int MIX> struct GlaCfg;
template <> struct GlaCfg<0> { static constexpr int PITCH = N0, CQ = C0_GQ, CK = C0_GK, CV = C0_GV, CG = C0_GR, OUTC = 512; };
template <> struct GlaCfg<1> { static constexpr int PITCH = N1, CQ = C1_HQ, CK = C1_HF, CV = C1_HI, CG = C1_HG, OUTC = 0; };
template <> struct GlaCfg<2> { static constexpr int PITCH = N1, CQ = C1_RQ, CK = C1_RK, CV = C1_RV, CG = C1_RG, OUTC = 512; };

__device__ __forceinline__ float logsigmoid_f(float z) { return fminf(z, 0.f) - log1pf(expf(-fabsf(z))); }

template <int MIX>
__device__ __forceinline__ void gla_load(Frame& F, int b, int head, int n, float (&q)[8], float (&k)[8], float (&bb)[8], float& blast, LAS float* part, bool need_q) {
    typedef GlaCfg<MIX> C; const Args& A = *F.a;
    const h16* Hh = (const h16*)(F.ws + WS_H); const int d = F.lane, w = F.wave;
    const size_t row0 = (size_t)b * SEQ + n * 64 + 8 * w; const int col = head * 64 + d;
    float la[8];
    if (MIX == 0) {
        float wg[16];
#pragma unroll
        for (int r = 0; r < 16; ++r) wg[r] = A.in[I_GLAWG][r * 256 + col];
        const float bg = A.in[I_GLABG][col];
#pragma unroll
        for (int i = 0; i < 8; ++i) { const h16* hr = Hh + (row0 + i) * C::PITCH;
            q[i] = need_q ? (float)hr[C::CQ + col] * 0.125f : 0.f; k[i] = (float)hr[C::CK + col];
            const h16x8 g0 = *(const h16x8*)(hr + C0_GA), g1 = *(const h16x8*)(hr + C0_GA + 8); float z = bg;
#pragma unroll
            for (int r = 0; r < 8; ++r) z += (float)g0[r] * wg[r] + (float)g1[r] * wg[8 + r];
            la[i] = logsigmoid_f(z) * (1.f / 16.f); }
    } else if (MIX == 1) {
        const float g0 = A.in[I_HGAMMA][col], g1 = A.in[I_HGAMMA][256 + col]; const float lb = 1.f / (1.f + expf(g0 - g1));
#pragma unroll
        for (int i = 0; i < 8; ++i) { const h16* hr = Hh + (row0 + i) * C::PITCH;
            q[i] = need_q ? (float)hr[C::CQ + col] : 0.f; const float hf = (float)hr[C::CK + col];
            const float f = lb + (1.f - lb) / (1.f + expf(-hf)); la[i] = logf(f); k[i] = 1.f - f; }
    } else {
        const float lg = log1pf(-exp2f(-5.f - (float)head));
        const float* rc = (const float*)(F.ws + WS_ROPE); const float* rs = rc + SEQ * 32;
#pragma unroll
        for (int i = 0; i < 8; ++i) { const h16* hr = Hh + (row0 + i) * C::PITCH; const int pos = n * 64 + 8 * w + i;
            const float cs = rc[pos * 32 + (d & 31)], sn = rs[pos * 32 + (d & 31)];
            const float xq = need_q ? (float)hr[C::CQ + col] : 0.f, xk = (float)hr[C::CK + col];
            const float pq = __shfl_xor(xq, 32), pk = __shfl_xor(xk, 32);
            q[i] = d < 32 ? xq * cs - pq * sn : pq * sn + xq * cs;
            k[i] = (d < 32 ? xk * cs - pk * sn : pk * sn + xk * cs) * 0.125f;
            la[i] = lg; }
    }
    float c = 0.f;
#pragma unroll
    for (int i = 0; i < 8; ++i) { c += la[i]; bb[i] = c; }
    part[w * 64 + d] = c;
    __syncthreads();
    float pre = 0.f, tot = 0.f;
#pragma unroll
    for (int w2 = 0; w2 < 8; ++w2) { const float pv = part[w2 * 64 + d]; tot += pv; if (w2 < w) pre += pv; }
#pragma unroll
    for (int i = 0; i < 8; ++i) bb[i] += pre;
    blast = tot;
}
template <int MIX>
__device__ __forceinline__ void gla_stage_vt(Frame& F, int b, int head, int n, LAS h16* Vt_l) {
    typedef GlaCfg<MIX> C; const h16* Hh = (const h16*)(F.ws + WS_H);
#pragma unroll
    for (int i = 0; i < 2; ++i) { const int id = F.tid + i * NTHR, r = id >> 4, ch = id & 15;
        const h16x8 v = *(const h16x8*)(Hh + ((size_t)b * SEQ + n * 64 + r) * C::PITCH + C::CV + head * 128 + ch * 8);
#pragma unroll
        for (int k2 = 0; k2 < 8; ++k2) Vt_l[(ch * 8 + k2) * GS + r] = v[k2]; }
}

template <int MIX>
__device__ __forceinline__ void gla_a_unit(Frame& F, int gidx, int b, int head, int n, h16* UT, float* DV) {
    LAS h16* KT_l = (LAS h16*)F.lds;
    LAS h16* Vt_l = (LAS h16*)(F.lds + 9216);
    LAS float* part = (LAS float*)(F.lds + 9216 + 18432);
    float q[8], k[8], bb[8], blast;
    __syncthreads();
    gla_load<MIX>(F, b, head, n, q, k, bb, blast, part, false);
    { h16x8 kv;
#pragma unroll
      for (int i = 0; i < 8; ++i) kv[i] = (h16)(k[i] * __expf(blast - bb[i]));
      *(LAS h16x8*)(KT_l + F.lane * GS + 8 * F.wave) = kv; }
    gla_stage_vt<MIX>(F, b, head, n, Vt_l);
    if (F.wave == 0) DV[((size_t)gidx * 256 + n) * 64 + F.lane] = __expf(blast);
    __syncthreads();
    const int fr = F.lane & 15, fq = F.lane >> 4, w = F.wave;
    const h16x8 a0 = *(const LAS h16x8*)(Vt_l + (16 * w + fr) * GS + 8 * fq), a1 = *(const LAS h16x8*)(Vt_l + (16 * w + fr) * GS + 32 + 8 * fq);
    h16* up = UT + ((size_t)gidx * 256 + n) * 8192;
#pragma unroll
    for (int dt = 0; dt < 4; ++dt) {
        const h16x8 b0 = *(const LAS h16x8*)(KT_l + (16 * dt + fr) * GS + 8 * fq), b1 = *(const LAS h16x8*)(KT_l + (16 * dt + fr) * GS + 32 + 8 * fq);
        f32x4 acc = (f32x4){0.f, 0.f, 0.f, 0.f};
        acc = __builtin_amdgcn_mfma_f32_16x16x32_f16(a0, b0, acc, 0, 0, 0);
        acc = __builtin_amdgcn_mfma_f32_16x16x32_f16(a1, b1, acc, 0, 0, 0);
#pragma unroll
        for (int r = 0; r < 4; ++r) up[(16 * w + 4 * fq + r) * 64 + 16 * dt + fr] = (h16)acc[r];
    }
}

__device__ __forceinline__ void gla_scan_unit(Frame& F, int u, const h16* UT, const float* DV, h16* ST) {
    const int gidx = u >> 2, e = (u & 3) * 32 + (F.tid >> 4), d4 = (F.tid & 15) * 4;
    const h16* up = UT + (size_t)gidx * 256 * 8192 + e * 64 + d4; h16* sp = ST + (size_t)gidx * 256 * 8192 + e * 64 + d4; const float* dp = DV + (size_t)gidx * 256 * 64 + d4;
    f32x4 S = (f32x4){0.f, 0.f, 0.f, 0.f};
    for (int nb = 0; nb < 256; nb += 8) {
        h16x4 uu[8]; f32x4 dd[8];
#pragma unroll
        for (int j = 0; j < 8; ++j) { uu[j] = *(const h16x4*)(up + (size_t)(nb + j) * 8192); dd[j] = *(const f32x4*)(dp + (nb + j) * 64); }
#pragma unroll
        for (int j = 0; j < 8; ++j) { h16x4 o; o[0] = (h16)S[0]; o[1] = (h16)S[1]; o[2] = (h16)S[2]; o[3] = (h16)S[3]; *(h16x4*)(sp + (size_t)(nb + j) * 8192) = o;
#pragma unroll
            for (int c = 0; c < 4; ++c) S[c] = S[c] * dd[j][c] + (float)uu[j][c]; }
    }
}

template <int MIX>
__device__ __forceinline__ void gla_c_unit(Frame& F, int gidx, int b, int head, int n, const h16* ST, h16* MX, const float* gw) {
    typedef GlaCfg<MIX> C;
    LAS h16* Qb_l = (LAS h16*)F.lds;
    LAS __bf16* QI_l = (LAS __bf16*)(F.lds + 9216);
    LAS __bf16* KI_l = (LAS __bf16*)(F.lds + 18432);
    LAS h16* P_l = (LAS h16*)(F.lds + 55296);
    LAS h16* Vt_l = (LAS h16*)(F.lds + 64512);
    LAS float* part = (LAS float*)(F.lds + 82944);
    LAS float* rI = (LAS float*)(F.lds + 84992);
    LAS float* stats = (LAS float*)(F.lds + 86016);
    float q[8], k[8], bb[8], blast;
    __syncthreads();
    gla_load<MIX>(F, b, head, n, q, k, bb, blast, part, true);
    const int d = F.lane, w = F.wave;
    if ((w & 1) == 0) rI[(w >> 1) * 64 + d] = bb[0];
    { unsigned zz = 0u; asm volatile("" : "+v"(zz)); const u32x4 z4 = (u32x4){zz, zz, zz, zz}; LAS u32x4* pz = (LAS u32x4*)P_l; pz[F.tid] = z4; if (F.tid < 64) pz[512 + F.tid] = z4; }
    gla_stage_vt<MIX>(F, b, head, n, Vt_l);
    __syncthreads();
    { const int I = w >> 1; float r[4];
#pragma unroll
      for (int I2 = 0; I2 < 4; ++I2) r[I2] = rI[I2 * 64 + d];
#pragma unroll
      for (int i = 0; i < 8; ++i) { const int t = 8 * w + i;
          Qb_l[t * GS + d] = (h16)(q[i] * __expf(bb[i]));
          QI_l[t * GS + d] = (__bf16)(q[i] * __expf(bb[i] - r[I]));
#pragma unroll
          for (int I2 = 0; I2 < 4; ++I2) if (I2 >= I) KI_l[(I2 * 64 + t) * GS + d] = (__bf16)(k[i] * __expf(fminf(r[I2] - bb[i], 80.f))); } }
    __syncthreads();
    const int fr = F.lane & 15, fq = F.lane >> 4;
    for (int p = w; p < 10; p += 8) {
        const int I = p >= 6 ? 3 : (p >= 3 ? 2 : (p >= 1 ? 1 : 0)), J = p - (I * (I + 1)) / 2;
        const LAS __bf16* ap = QI_l + (16 * I + fr) * GS + 8 * fq; const LAS __bf16* bp = KI_l + (I * 64 + 16 * J + fr) * GS + 8 * fq;
        f32x4 acc = (f32x4){0.f, 0.f, 0.f, 0.f};
        acc = __builtin_amdgcn_mfma_f32_16x16x32_bf16(*(const LAS b16x8*)ap, *(const LAS b16x8*)bp, acc, 0, 0, 0);
        acc = __builtin_amdgcn_mfma_f32_16x16x32_bf16(*(const LAS b16x8*)(ap + 32), *(const LAS b16x8*)(bp + 32), acc, 0, 0, 0);
#pragma unroll
        for (int r = 0; r < 4; ++r) { const int tl = 4 * fq + r; const float v = (I == J && fr > tl) ? 0.f : acc[r]; P_l[(16 * I + tl) * GS + 16 * J + fr] = (h16)v; }
    }
    __syncthreads();
    const int tt = w >> 1, eh = w & 1;
    const h16x8 p0 = *(const LAS h16x8*)(P_l + (16 * tt + fr) * GS + 8 * fq), p1 = *(const LAS h16x8*)(P_l + (16 * tt + fr) * GS + 32 + 8 * fq);
    const h16x8 qb0 = *(const LAS h16x8*)(Qb_l + (16 * tt + fr) * GS + 8 * fq), qb1 = *(const LAS h16x8*)(Qb_l + (16 * tt + fr) * GS + 32 + 8 * fq);
    const h16* sp = ST + ((size_t)gidx * 256 + n) * 8192;
    f32x4 o[4]; float s1[4] = {0.f, 0.f, 0.f, 0.f}, s2[4] = {0.f, 0.f, 0.f, 0.f};
#pragma unroll
    for (int et = 0; et < 4; ++et) { const int e0 = 64 * eh + 16 * et;
        const h16x8 v0 = *(const LAS h16x8*)(Vt_l + (e0 + fr) * GS + 8 * fq), v1 = *(const LAS h16x8*)(Vt_l + (e0 + fr) * GS + 32 + 8 * fq);
        const h16x8 t0 = *(const h16x8*)(sp + (e0 + fr) * 64 + 8 * fq), t1 = *(const h16x8*)(sp + (e0 + fr) * 64 + 32 + 8 * fq);
        f32x4 acc = (f32x4){0.f, 0.f, 0.f, 0.f};
        acc = __builtin_amdgcn_mfma_f32_16x16x32_f16(p0, v0, acc, 0, 0, 0);
        acc = __builtin_amdgcn_mfma_f32_16x16x32_f16(p1, v1, acc, 0, 0, 0);
        acc = __builtin_amdgcn_mfma_f32_16x16x32_f16(qb0, t0, acc, 0, 0, 0);
        acc = __builtin_amdgcn_mfma_f32_16x16x32_f16(qb1, t1, acc, 0, 0, 0);
        o[et] = acc;
#pragma unroll
        for (int r = 0; r < 4; ++r) { s1[r] += acc[r]; s2[r] += acc[r] * acc[r]; } }
#pragma unroll
    for (int r = 0; r < 4; ++r) {
#pragma unroll
        for (int x = 1; x < 16; x <<= 1) { s1[r] += __shfl_xor(s1[r], x); s2[r] += __shfl_xor(s2[r], x); }
        if (fr == 0) { const int t = 16 * tt + 4 * fq + r; stats[(t * 2 + eh) * 2] = s1[r]; stats[(t * 2 + eh) * 2 + 1] = s2[r]; } }
    __syncthreads();
    const h16* Hh = (const h16*)(F.ws + WS_H);
#pragma unroll
    for (int r = 0; r < 4; ++r) { const int t = 16 * tt + 4 * fq + r;
        const float a1 = stats[(t * 2) * 2] + stats[(t * 2 + 1) * 2], a2 = stats[(t * 2) * 2 + 1] + stats[(t * 2 + 1) * 2 + 1];
        float mean = 0.f, rstd;
        if (MIX == 2) { mean = a1 * (1.f / 128.f); const float var = fmaxf(a2 * (1.f / 128.f) - mean * mean, 0.f); rstd = 1.f / sqrtf(var + HEAD_EPS); }
        else rstd = 1.f / sqrtf(a2 * (1.f / 128.f) + HEAD_EPS);
        const size_t row = (size_t)b * SEQ + n * 64 + t;
#pragma unroll
        for (int et = 0; et < 4; ++et) { const int e = 64 * eh + 16 * et + fr; const float g = (float)Hh[row * C::PITCH + C::CG + head * 128 + e];
            const float y = (o[et][r] - mean) * rstd * gw[head * 128 + e] * pg8::silu_f(g);
            MX[row * DM + C::OUTC + head * 128 + e] = (h16)y; } }
}

__device__ __forceinline__ void p_xconv_gather(Frame& F) {
    const Args& A = *F.a; unsigned char* ws = F.ws;
    LAS float* scr = (LAS float*)(F.lds + F.wave * 16384);
    LAS int* ps_l = (LAS int*)(F.lds + LDS_X_OFF);
    const int gw = F.vcu * NWAVES + F.wave, NGW = F.G * NWAVES;
    if (F.tid == 0) {
        int acc = 0; int* meta = (int*)(ws + WS_META);
        for (int e = 0; e < 8; ++e) { const int c = (int)__hip_atomic_load(F.ctl + CW_MOECNT + e, RLX_AGENT); ps_l[e] = acc;
            if (blockIdx.x == 0) { meta[e] = c; meta[8 + e] = acc; const int np = (c + 255) >> 8; for (int p = 0; p < np; ++p) meta[32 + (acc >> 8) + p] = e; }
            acc += ((c + 255) >> 8) << 8; }
        if (blockIdx.x == 0) meta[16] = acc >> 8;
    }
    __syncthreads();
    { const h16* xa = (const h16*)(ws + WS_XA); h16* xs = (h16*)(ws + WS_XS); int* route = (int*)(ws + WS_ROUTE); int* rowslot = (int*)(ws + WS_ROWSLOT);
      for (int t = gw; t < M; t += NGW) { const int* rr = route + (size_t)t * 8; const int r0 = ps_l[rr[0]] + rr[1], r1 = ps_l[rr[2]] + rr[3];
          const h16x8 a = *(const h16x8*)(xa + (size_t)t * DM + F.lane * 8), b = *(const h16x8*)(xa + (size_t)t * DM + 512 + F.lane * 8);
          *(h16x8*)(xs + (size_t)r0 * DM + F.lane * 8) = a; *(h16x8*)(xs + (size_t)r0 * DM + 512 + F.lane * 8) = b;
          *(h16x8*)(xs + (size_t)r1 * DM + F.lane * 8) = a; *(h16x8*)(xs + (size_t)r1 * DM + 512 + F.lane * 8) = b;
          if (F.lane == 0) { rowslot[r0] = 2 * t; rowslot[r1] = 2 * t + 1; } } }
    constexpr int TI = 1792, NT = 8 * 3 * TI;
    for (int it = gw; it < NT; it += NGW) {
        const int e = it / (3 * TI), r = it % (3 * TI), which = r / TI, item = r % TI;
        if (which == 0) transpose_item(A.in[I_XW1] + (size_t)e * 1024 * FE, FE, (h16*)(ws + WS_E13) + (size_t)e * 7168 * 1024, 1024, 2, scr, item, F.lane);
        else if (which == 1) transpose_item(A.in[I_XW3] + (size_t)e * 1024 * FE, FE, (h16*)(ws + WS_E13) + (size_t)e * 7168 * 1024, 1024, 3, scr, item, F.lane);
        else transpose_item(A.in[I_XW2] + (size_t)e * FE * 1024, 1024, (h16*)(ws + WS_E2) + (size_t)e * 1024 * FE, FE, 0, scr, item, F.lane);
    }
}

constexpr int NPH = 33;
#ifndef MK_PER_PHASE
#define MK_PER_PHASE 0
#endif
#if MK_PER_PHASE
#define PH_LO args.ph_lo
#define PH_HI args.ph_hi
#else
#define PH_LO 0
#define PH_HI NPH
#endif
#ifndef PHMASK
#define PHMASK 0xffffffffffffull
#endif
#define IN(k) (((PHMASK >> ((k) >= 20 && (k) < 30 ? 20 + ((k) & 1) : (k))) & 1ull) && PH_LO <= (k) && (k) < PH_HI)
#ifndef REPMASK
#define REPMASK 0ull
#endif
#define REP(k) ((int)((REPMASK >> ((k) >= 20 && (k) < 30 ? 20 + ((k) & 1) : (k))) & 1ull))
#define SEAM(k) do { if (IN(k) && IN((k) + 1)) xcd_barrier(bar); } while (0)
#define XA ((h16*)(F.ws + WS_XA))
#define XB ((h16*)(F.ws + WS_XB))
#define Hb ((h16*)(F.ws + WS_H))
#define Yb ((h16*)(F.ws + WS_Y))
template <int L>
__device__ __forceinline__ void run_layer(Frame& F, const Args& args, const XcdBarrier& bar) {
    const int cid = (int)blockIdx.x;
        const int p_in = L ? 13 : 1, p_out = L ? 17 : 6, p_lnb = L ? 30 : 10;
#define Xin (L ? XB : XA)
#define Xmid (L ? XA : XB)
#define Xffn (L ? XB : XA)
#define MXb ((h16*)(F.ws + (L ? WS_MIXIN1 : WS_MIXIN0)))
        if (IN(p_in)) for (int rep_ = 0; rep_ <= REP(p_in); ++rep_) { launder(F); __syncthreads(); const int N = L ? N1 : N0;
            pg8::Gemm g{Xin, (const h16*)(F.ws + (L ? WS_WIN1 : WS_WIN0)), 1024}; pg8::StaticOrder S; S.init(M, N, F.G, cid);
            pg8::EpiStoreH E{Hb, N};
            pg8::gemm_phase<pg8::EpiStoreH, pg8::StaticOrder, true>(F.lds, g, S, E); }
        SEAM(p_in);
        if (L == 0) {
            if (IN(2)) for (int rep_ = 0; rep_ <= REP(2); ++rep_) { launder(F); __syncthreads(); for (int u = F.vcu; u < 128 + 2048; u += F.G) { if (u < 128) moba_kmean_unit(F, u); else { const int v = u - 128, gi = v >> 8, n = v & 255; gla_a_unit<0>(F, gi, gi >> 2, gi & 3, n, (h16*)(F.ws + WS_U0), (float*)(F.ws + WS_DV0)); } } }
            SEAM(2);
            if (IN(3)) for (int rep_ = 0; rep_ <= REP(3); ++rep_) { launder(F); __syncthreads(); for (int u = F.vcu; u < 32 + 1008; u += F.G) { if (u < 32) gla_scan_unit(F, u, (const h16*)(F.ws + WS_U0), (const float*)(F.ws + WS_DV0), (h16*)(F.ws + WS_ST0)); else if (rep_ == 0) moba_select_unit(F, u - 32); } }
            SEAM(3);
            if (IN(4)) for (int rep_ = 0; rep_ <= REP(4); ++rep_) { launder(F); __syncthreads(); moba_sparse_phase(F); }
            SEAM(4);
            if (IN(5)) for (int rep_ = 0; rep_ <= REP(5); ++rep_) { launder(F); __syncthreads(); for (int u = F.vcu; u < 1024 + 2048; u += F.G) { if (u < 1024) moba_own_unit(F, u); else { const int v = u - 1024, gi = v >> 8, n = v & 255; gla_c_unit<0>(F, gi, gi >> 2, gi & 3, n, (const h16*)(F.ws + WS_ST0), MXb, args.in[I_GLAN]); } } }
            SEAM(5);
        } else {
            if (IN(14)) for (int rep_ = 0; rep_ <= REP(14); ++rep_) { launder(F); __syncthreads(); for (int u = F.vcu; u < 4096; u += F.G) { const int gi = u >> 8, n = u & 255, bh = gi & 7;
                if (gi < 8) gla_a_unit<1>(F, gi, bh >> 2, bh & 3, n, (h16*)(F.ws + WS_U1), (float*)(F.ws + WS_DV1)); else gla_a_unit<2>(F, gi, bh >> 2, bh & 3, n, (h16*)(F.ws + WS_U1), (float*)(F.ws + WS_DV1)); } }
            SEAM(14);
            if (IN(15)) for (int rep_ = 0; rep_ <= REP(15); ++rep_) { launder(F); __syncthreads(); for (int u = F.vcu; u < 64; u += F.G) gla_scan_unit(F, u, (const h16*)(F.ws + WS_U1), (const float*)(F.ws + WS_DV1), (h16*)(F.ws + WS_ST1)); }
            SEAM(15);
            if (IN(16)) for (int rep_ = 0; rep_ <= REP(16); ++rep_) { launder(F); __syncthreads(); for (int u = F.vcu; u < 4096; u += F.G) { const int gi = u >> 8, n = u & 255, bh = gi & 7;
                if (gi < 8) gla_c_unit<1>(F, gi, bh >> 2, bh & 3, n, (const h16*)(F.ws + WS_ST1), MXb, args.in[I_HNORM]); else gla_c_unit<2>(F, gi, bh >> 2, bh & 3, n, (const h16*)(F.ws + WS_ST1), MXb, args.in[I_RNORM]); } }
            SEAM(16);
        }
        if (IN(p_out)) for (int rep_ = 0; rep_ <= REP(p_out); ++rep_) { launder(F); __syncthreads(); pg8::Gemm g{MXb, (const h16*)(F.ws + (L ? WS_WOUT1 : WS_WOUT0)), 1024}; pg8::StaticOrder S; S.init(M, 1024, F.G, cid);
            pg8::EpiResid E{Yb, Xin};
            pg8::gemm_phase<pg8::EpiResid, pg8::StaticOrder, true>(F.lds, g, S, E); }
        SEAM(p_out);
        if (IN(p_out + 1)) for (int rep_ = 0; rep_ <= REP(p_out + 1); ++rep_) { launder(F); __syncthreads(); __syncthreads();
            if (L == 0) ln_phase<0>(F, Yb, args.in[I_LMG], args.in[I_LMB], Xmid, nullptr, nullptr);
            else ln_phase<1>(F, Yb, args.in[I_LMG] + 1024, args.in[I_LMB] + 1024, Xmid, nullptr, nullptr); }
        SEAM(p_out + 1);
        if (L == 0) {
            if (IN(8)) for (int rep_ = 0; rep_ <= REP(8); ++rep_) { launder(F); __syncthreads(); pg8::Gemm g{Xmid, (const h16*)(F.ws + WS_W13_0), 1024}; pg8::StaticOrder S; S.init(M, 2 * FDP, F.G, cid);
                pg8::EpiSwiGLU E{(h16*)(F.ws + WS_HID), FDP};
                pg8::gemm_phase<pg8::EpiSwiGLU, pg8::StaticOrder, true>(F.lds, g, S, E); }
            SEAM(8);
            if (IN(9)) for (int rep_ = 0; rep_ <= REP(9); ++rep_) { launder(F); __syncthreads(); pg8::Gemm g{(const h16*)(F.ws + WS_HID), (const h16*)(F.ws + WS_W2_0), FDP}; pg8::StaticOrder S; S.init(M, 1024, F.G, cid);
                pg8::EpiResid E{Yb, Xmid};
                pg8::gemm_phase<pg8::EpiResid, pg8::StaticOrder, true>(F.lds, g, S, E); }
            SEAM(9);
        } else {
            if (IN(19)) for (int rep_ = 0; rep_ <= REP(19); ++rep_) { launder(F); __syncthreads(); __syncthreads(); p_xconv_gather(F); }
            SEAM(19);
#define meta ((const int*)(F.ws + WS_META))
#pragma unroll 1
            for (int q = 0; q < MOE_PASSES; ++q) {
                const int pu = 20 + 2 * q;
                if (IN(pu)) for (int rep_ = 0; rep_ <= REP(pu); ++rep_) { launder(F); __syncthreads(); const int PT = __builtin_amdgcn_readfirstlane(meta[16]); const int P0 = MOE_PPP * q, P1 = (P0 + MOE_PPP) < PT ? (P0 + MOE_PPP) : PT;
                    pg8::Gemm g{(const h16*)(F.ws + WS_XS), (const h16*)(F.ws + WS_E13), 1024}; pg8::MoeOrder S; S.init(P0, P1, 28, F.G, cid, 1, meta + 32);
                    pg8::EpiSwiGLU E{(h16*)(F.ws + WS_HQ), FE};
                    pg8::gemm_phase<pg8::EpiSwiGLU, pg8::MoeOrder, true>(F.lds, g, S, E); }
                SEAM(pu);
                if (IN(pu + 1)) for (int rep_ = 0; rep_ <= REP(pu + 1); ++rep_) { launder(F); __syncthreads(); const int PT = __builtin_amdgcn_readfirstlane(meta[16]); const int P0 = MOE_PPP * q, P1 = (P0 + MOE_PPP) < PT ? (P0 + MOE_PPP) : PT;
                    pg8::Gemm g{(const h16*)(F.ws + WS_HQ), (const h16*)(F.ws + WS_E2), FE}; pg8::MoeOrder S; S.init(P0, P1, 4, F.G, cid, 0, meta + 32);
                    pg8::EpiMoeDown E{(h16*)args.out, (const int*)(F.ws + WS_ROWSLOT), meta};
                    pg8::gemm_phase<pg8::EpiMoeDown, pg8::MoeOrder, true>(F.lds, g, S, E); }
                SEAM(pu + 1);
            }
        }
        if (IN(p_lnb)) for (int rep_ = 0; rep_ <= REP(p_lnb); ++rep_) { launder(F); __syncthreads(); __syncthreads();
            if (L == 0) ln_phase<0>(F, Yb, args.in[I_LFG], args.in[I_LFB], Xffn, nullptr, nullptr);
            else ln_phase<2>(F, nullptr, args.in[I_LFG] + 1024, args.in[I_LFB] + 1024, Xffn, Xmid, (const h16*)args.out); }
        SEAM(p_lnb);
        if (IN(p_lnb + 1)) for (int rep_ = 0; rep_ <= REP(p_lnb + 1); ++rep_) { launder(F); __syncthreads(); pg8::Gemm g{(const h16*)(F.ws + WS_PH) + (size_t)L * M * PLE, (const h16*)(F.ws + (L ? WS_WP1 : WS_WP0)), PLE}; pg8::StaticOrder S; S.init(M, 1024, F.G, cid);
            pg8::EpiStoreH E{(h16*)(F.ws + WS_PP), 1024};
            pg8::gemm_phase<pg8::EpiStoreH, pg8::StaticOrder, true>(F.lds, g, S, E); }
        SEAM(p_lnb + 1);
        if (IN(p_lnb + 2)) for (int rep_ = 0; rep_ <= REP(p_lnb + 2); ++rep_) { launder(F); __syncthreads(); pg8::Gemm g{Xffn, (const h16*)(F.ws + (L ? WS_WG1 : WS_WG0)), 1024}; pg8::StaticOrder S; S.init(M, 1024, F.G, cid);
            pg8::EpiPle E{Xffn, (const h16*)(F.ws + WS_PP), L ? XA : XB, args.out, L};
            pg8::gemm_phase<pg8::EpiPle, pg8::StaticOrder, true>(F.lds, g, S, E); }
        if (L == 0) SEAM(12);
    }
__global__ void __launch_bounds__(NTHR, 2) hyb_fwd(Args args) {
    extern __shared__ __attribute__((aligned(16))) unsigned char lds_raw[];
    Frame F;
    F.lds = (LAS unsigned char*)lds_raw; F.tid = threadIdx.x; F.lane = F.tid & 63; F.wave = __builtin_amdgcn_readfirstlane(F.tid >> 6);
    F.G = gridDim.x; { const int bx = blockIdx.x; F.vcu = (F.G % 8 == 0) ? (bx % 8) * (F.G / 8) + bx / 8 : bx; }
    F.ws = args.ws; F.ctl = (gu32*)(args.ws + WS_CTL); F.a = &args;
    if (F.tid < 64) ((LAS unsigned*)(F.lds + LDSCTL_OFF))[F.tid] = 0u;
    __syncthreads();
    XcdBarrier bar; bar.bar = (unsigned*)(F.ctl + CW_BAR); bar.x = 0; bar.st = (volatile LAS unsigned*)(F.lds + LDSCTL_OFF + 32);
    if (PH_HI - PH_LO > 1) bar = xcd_barrier_post((unsigned*)(F.ctl + CW_BAR), (volatile LAS unsigned*)(F.lds + LDSCTL_OFF + 32));
    const int cid = (int)blockIdx.x;

    if (IN(0)) for (int rep_ = 0; rep_ <= REP(0); ++rep_) { launder(F); __syncthreads(); p_prologue(F); }
    SEAM(0);
    run_layer<0>(F, args, bar);
    run_layer<1>(F, args, bar);
#undef XA
#undef XB
#undef Hb
#undef Yb
#undef Xin
#undef Xmid
#undef Xffn
#undef MXb
#undef meta
#undef IN
#undef SEAM
}

#ifndef MK_PER_PHASE
#define MK_PER_PHASE 0
#endif
extern "C" void kernel_launch(void* const* d_in, const int* in_sizes, int n_in, void* d_out, int out_size, void* d_ws, size_t ws_size, hipStream_t stream) {
    static int grid = 0;
    if (grid == 0) {
        if (n_in != 27 || in_sizes[0] != M * DM || out_size != M * DM || ws_size < WS_END) { fprintf(stderr, "kernel_launch: unexpected shapes (n_in %d, in0 %d, out %d, ws %zu); nothing launched\n", n_in, n_in > 0 ? in_sizes[0] : -1, out_size, ws_size); grid = -1; return; }
        int dev = 0, cus = 0, per_cu = 0;
        if (hipGetDevice(&dev) != hipSuccess || hipDeviceGetAttribute(&cus, hipDeviceAttributeMultiprocessorCount, dev) != hipSuccess) { grid = -1; return; }
        if (hipFuncSetAttribute((const void*)hyb_fwd, hipFuncAttributeMaxDynamicSharedMemorySize, LDS_BYTES) != hipSuccess) { fprintf(stderr, "kernel_launch: hipFuncSetAttribute failed\n"); grid = -1; return; }
        if (hipOccupancyMaxActiveBlocksPerMultiprocessor(&per_cu, (const void*)hyb_fwd, NTHR, LDS_BYTES) != hipSuccess || per_cu < 1) fprintf(stderr, "kernel_launch: occupancy query reports %d\n", per_cu);
        (void)hipGetLastError();
        grid = cus;
    }
    if (grid < 0) return;
    if (hipMemsetAsync((char*)d_ws + WS_CTL, 0, CTL_ZERO_BYTES, stream) != hipSuccess) return;
    Args a{};
    for (int i = 0; i < 27; ++i) a.in[i] = (const float*)d_in[i];
    a.out = (float*)d_out; a.ws = (unsigned char*)d_ws;
#if MK_PER_PHASE
    for (int ph = 0; ph < NPH; ++ph) { a.ph_lo = ph; a.ph_hi = ph + 1; hipLaunchKernelGGL(hyb_fwd, dim3(grid), dim3(NTHR), LDS_BYTES, stream, a); }
#else
    a.ph_lo = 0; a.ph_hi = NPH; hipLaunchKernelGGL(hyb_fwd, dim3(grid), dim3(NTHR), LDS_BYTES, stream, a);
#endif
}
```

```cpp
#include <hip/hip_runtime.h>
#include <cstdio>
#include <cstdint>

#define LAS __attribute__((address_space(3)))
#define GAS __attribute__((address_space(1)))
typedef _Float16 h16;
typedef _Float16 h16x8 __attribute__((ext_vector_type(8)));
typedef _Float16 h16x4 __attribute__((ext_vector_type(4)));
typedef _Float16 h16x2 __attribute__((ext_vector_type(2)));
typedef __bf16 b16x8 __attribute__((ext_vector_type(8)));
typedef float f32x4 __attribute__((ext_vector_type(4)));
typedef float f32x2 __attribute__((ext_vector_type(2)));
typedef unsigned u32x4 __attribute__((ext_vector_type(4)));
typedef unsigned u32x2 __attribute__((ext_vector_type(2)));
typedef GAS unsigned gu32;
#define RLX_AGENT __ATOMIC_RELAXED, __HIP_MEMORY_SCOPE_AGENT
#define LDS_WAIT() asm volatile("s_waitcnt lgkmcnt(0)" ::: "memory")
#define VM_WAIT() asm volatile("s_waitcnt vmcnt(0)" ::: "memory")

constexpr int BATCH = 2, SEQ = 16384, DM = 1024, M = BATCH * SEQ;
constexpr int NWAVES = 8, NTHR = 512;
constexpr float DN_ALPHA = 1.4142135623730951f;
constexpr float LN_EPS = 1e-5f, HEAD_EPS = 1e-6f;
constexpr int N0 = 3328;
constexpr int N1 = 3072;
constexpr int C0_MQ = 0, C0_MK = 512, C0_MV = 1024, C0_GQ = 1536, C0_GK = 1792, C0_GV = 2048, C0_GR = 2560, C0_GA = 3072;
constexpr int C1_HQ = 0, C1_HF = 256, C1_HI = 512, C1_HG = 1024, C1_RQ = 1536, C1_RK = 1792, C1_RV = 2048, C1_RG = 2560;
constexpr int FD = 2752, FDP = 2816;
constexpr int FE = 3584, NEXP = 8;
constexpr int PLE = 256;
constexpr int MOE_PANELS = 264;
constexpr int MOE_PASSES = 5, MOE_PPP = 64;

namespace pg8 {
constexpr int BM = 256, BK = 64, HALF = 128, HTB = HALF * BK * 2, STAGE_BYTES = 8 * HTB, NXCD = 8, WGM = 8;
__host__ __device__ __forceinline__ int lds_byte(int r, int c) { const int st = (r >> 4) * 2 + (c >> 5), rr = r & 15, cc = c & 31, ob = rr * 64 + cc * 2; return st * 1024 + (ob ^ (((ob >> 9) & 1) << 5)); }
__host__ __device__ __forceinline__ void stage_rc(int b, int& R, int& C) { const int st = b / 1024, sb = b % 1024, swz = sb ^ (((sb >> 9) & 1) << 5); R = (st >> 1) * 16 + swz / 64; C = (st & 1) * 32 + (swz % 64) / 2; }
__host__ __device__ __forceinline__ int perm32(int rho) { const int n = rho >> 4, i = rho & 15; return 8 * (i >> 2) + 4 * n + (i & 3); }

struct Unit { int pa, pb, pm, pn; };
struct Gemm { const h16* A; const h16* Bt; int K; };

struct StaticOrder {
    int nM, nN, nwg, G, c;
    __device__ void init(int Mrows, int N, int G_, int c_) { nM = Mrows / BM; nN = N / BM; nwg = nM * nN; G = G_; c = c_; }
    __device__ bool next(int i, Unit& u) const {
        const long L = (long)i * G + c; if (L >= nwg) return false;
        int wgid = (int)L; { const int q = nwg / NXCD, r = nwg % NXCD, xcd = wgid % NXCD, off = wgid / NXCD; wgid = (xcd < r ? xcd * (q + 1) : r * (q + 1) + (xcd - r) * q) + off; }
        const int nig = WGM * nN, gid = wgid / nig, fm = gid * WGM, gsz = (nM - fm) < WGM ? (nM - fm) : WGM;
        u.pm = fm + ((wgid % nig) % gsz); u.pn = (wgid % nig) / gsz; u.pa = u.pm; u.pb = u.pn; return true;
    }
};
struct MoeOrder {
    int P0, nM, nN, nwg, G, c, up; const int* pexp;
    __device__ void init(int P0_, int P1_, int nN_, int G_, int c_, int up_, const int* pexp_) { P0 = P0_; nM = P1_ - P0_; if (nM < 0) nM = 0; nN = nN_; nwg = nM * nN; G = G_; c = c_; up = up_; pexp = pexp_; }
    __device__ bool next(int i, Unit& u) const {
        const long L = (long)i * G + c; if (L >= nwg) return false;
        int wgid = (int)L; { const int q = nwg / NXCD, r = nwg % NXCD, xcd = wgid % NXCD, off = wgid / NXCD; wgid = (xcd < r ? xcd * (q + 1) : r * (q + 1) + (xcd - r) * q) + off; }
        const int nig = WGM * nN, gid = wgid / nig, fm = gid * WGM, gsz = (nM - fm) < WGM ? (nM - fm) : WGM;
        const int pl = fm + ((wgid % nig) % gsz), pn = (wgid % nig) / gsz;
        const int e = __builtin_amdgcn_readfirstlane(pexp[P0 + pl]);
        u.pn = pn; u.pb = e * nN + pn;
        if (up) { u.pa = P0 + pl; u.pm = pl; } else { u.pa = pl; u.pm = P0 + pl; }
        return true;
    }
};

__device__ __forceinline__ h16x8 pack8(const f32x4 a, const f32x4 b) { h16x8 w; w[0] = (h16)a[0]; w[1] = (h16)a[1]; w[2] = (h16)a[2]; w[3] = (h16)a[3]; w[4] = (h16)b[0]; w[5] = (h16)b[1]; w[6] = (h16)b[2]; w[7] = (h16)b[3]; return w; }
__device__ __forceinline__ float silu_f(float x) { return x * __builtin_amdgcn_rcpf(1.0f + __expf(-x)); }
__device__ __forceinline__ float sigmoid_f(float x) { return __builtin_amdgcn_rcpf(1.0f + __expf(-x)); }

struct EpiStoreH {
    h16* O; int ldc;
    __device__ __forceinline__ void operator()(const f32x4 (&acc)[2][2][4][2], const Unit& u, int wr, int wc, int fr, int fq) const {
        const int row0 = u.pm * BM + wr * 64 + fr, col0 = u.pn * BM + wc * 32 + 8 * fq;
#pragma unroll
        for (int ai = 0; ai < 2; ++ai)
#pragma unroll
            for (int m = 0; m < 4; ++m) { h16* rowp = O + (size_t)(row0 + ai * HALF + m * 16) * ldc + col0;
#pragma unroll
                for (int bj = 0; bj < 2; ++bj) *(h16x8*)(rowp + bj * HALF) = pack8(acc[ai][bj][m][0], acc[ai][bj][m][1]); }
    }
};
struct EpiResid {
    h16* Y; const h16* R;
    __device__ __forceinline__ void operator()(const f32x4 (&acc)[2][2][4][2], const Unit& u, int wr, int wc, int fr, int fq) const {
        const int row0 = u.pm * BM + wr * 64 + fr, col0 = u.pn * BM + wc * 32 + 8 * fq;
#pragma unroll
        for (int ai = 0; ai < 2; ++ai) {
            h16x8 rr[4][2];
#pragma unroll
            for (int m = 0; m < 4; ++m)
#pragma unroll
                for (int bj = 0; bj < 2; ++bj) rr[m][bj] = *(const h16x8*)(R + (size_t)(row0 + ai * HALF + m * 16) * DM + col0 + bj * HALF);
#pragma unroll
            for (int m = 0; m < 4; ++m) { const size_t off = (size_t)(row0 + ai * HALF + m * 16) * DM + col0;
#pragma unroll
                for (int bj = 0; bj < 2; ++bj) { const h16x8 r = rr[m][bj]; const f32x4 a = acc[ai][bj][m][0], b = acc[ai][bj][m][1]; h16x8 w;
#pragma unroll
                    for (int j = 0; j < 4; ++j) { w[j] = (h16)(DN_ALPHA * (float)r[j] + a[j]); w[4 + j] = (h16)(DN_ALPHA * (float)r[4 + j] + b[j]); }
                    *(h16x8*)(Y + off + bj * HALF) = w; } }
            asm volatile("" ::: "memory");
        }
    }
};
struct EpiSwiGLU {
    h16* Hd; int ldh;
    __device__ __forceinline__ void operator()(const f32x4 (&acc)[2][2][4][2], const Unit& u, int wr, int wc, int fr, int fq) const {
        const int row0 = u.pm * BM + wr * 64 + fr, col0 = u.pn * HALF + wc * 32 + 8 * fq;
#pragma unroll
        for (int ai = 0; ai < 2; ++ai)
#pragma unroll
            for (int m = 0; m < 4; ++m) { h16x8 w;
#pragma unroll
                for (int n = 0; n < 2; ++n)
#pragma unroll
                    for (int j = 0; j < 4; ++j) w[4 * n + j] = (h16)(silu_f(acc[ai][0][m][n][j]) * acc[ai][1][m][n][j]);
                *(h16x8*)(Hd + (size_t)(row0 + ai * HALF + m * 16) * ldh + col0) = w; }
    }
};
struct EpiPle {
    const h16* X; const h16* PP; h16* Oh; float* Of; int fin;
    __device__ __forceinline__ void operator()(const f32x4 (&acc)[2][2][4][2], const Unit& u, int wr, int wc, int fr, int fq) const {
        const int row0 = u.pm * BM + wr * 64 + fr, col0 = u.pn * BM + wc * 32 + 8 * fq;
#pragma unroll
        for (int ai = 0; ai < 2; ++ai)
#pragma unroll
            for (int mh = 0; mh < 2; ++mh) {
                h16x8 xx[2][2], pp[2][2];
#pragma unroll
                for (int m2 = 0; m2 < 2; ++m2)
#pragma unroll
                    for (int bj = 0; bj < 2; ++bj) { const size_t off = (size_t)(row0 + ai * HALF + (2 * mh + m2) * 16) * DM + col0 + bj * HALF; xx[m2][bj] = *(const h16x8*)(X + off); pp[m2][bj] = *(const h16x8*)(PP + off); }
#pragma unroll
                for (int m2 = 0; m2 < 2; ++m2) { const int m = 2 * mh + m2; const size_t off = (size_t)(row0 + ai * HALF + m * 16) * DM + col0;
#pragma unroll
                    for (int bj = 0; bj < 2; ++bj) { const h16x8 x = xx[m2][bj], p = pp[m2][bj]; const f32x4 a = acc[ai][bj][m][0], b = acc[ai][bj][m][1];
                        f32x4 o0, o1;
#pragma unroll
                        for (int j = 0; j < 4; ++j) { o0[j] = (float)x[j] + sigmoid_f(a[j]) * (float)p[j]; o1[j] = (float)x[4 + j] + sigmoid_f(b[j]) * (float)p[4 + j]; }
                        if (fin) { *(f32x4*)(Of + off + bj * HALF) = o0; *(f32x4*)(Of + off + bj * HALF + 4) = o1; }
                        else *(h16x8*)(Oh + off + bj * HALF) = pack8(o0, o1); } }
                asm volatile("" ::: "memory");
            }
    }
};
struct EpiMoeDown {
    h16* ys; const int* rowslot; const int* meta;
    __device__ __forceinline__ void operator()(const f32x4 (&acc)[2][2][4][2], const Unit& u, int wr, int wc, int fr, int fq) const {
        const int row0 = u.pm * BM + wr * 64 + fr, col0 = u.pn * BM + wc * 32 + 8 * fq;
        const int e = u.pb >> 2;
        const int lim = meta[8 + e] + meta[e];
        int slot[2][4];
#pragma unroll
        for (int ai = 0; ai < 2; ++ai)
#pragma unroll
            for (int m = 0; m < 4; ++m) { const int r = row0 + ai * HALF + m * 16; slot[ai][m] = r < lim ? rowslot[r] : -1; }
#pragma unroll
        for (int ai = 0; ai < 2; ++ai)
#pragma unroll
            for (int m = 0; m < 4; ++m) {
                if (slot[ai][m] >= 0) { h16* rowp = ys + (size_t)slot[ai][m] * DM + col0;
#pragma unroll
                    for (int bj = 0; bj < 2; ++bj) *(h16x8*)(rowp + bj * HALF) = pack8(acc[ai][bj][m][0], acc[ai][bj][m][1]); } }
    }
};

template <class Epi, class Sched, bool ALIGN_EPI>
__device__ __forceinline__ void gemm_phase(LAS unsigned char* lds, const Gemm g, const Sched& S, const Epi& E) {
    int tid_ = threadIdx.x; asm volatile("" : "+v"(tid_));
    const int tid = tid_, wid = __builtin_amdgcn_readfirstlane(tid >> 6), lane = tid & 63, wr = wid >> 2, wc = wid & 3, fr = lane & 15, fq = lane >> 4;
    const int K = g.K, nt = K / BK;
    unsigned voffA[2], voffB[2];
#pragma unroll
    for (int i = 0; i < 2; ++i) { int R, C; stage_rc(tid * 16 + i * 8192, R, C); const int Rb = (R & ~31) + perm32(R & 31);
        voffA[i] = (unsigned)(R * K + C) * 2u; voffB[i] = (unsigned)(Rb * K + C) * 2u; }
    const size_t kstep = (size_t)(BK * 2);
    const size_t hstep = (size_t)HALF * K * 2;
    const size_t tstep = 2 * hstep;
    const unsigned ldsw = (unsigned)wid * 1024u;
    const int aoff = lds_byte(wr * 64 + fr, fq * 8), boff = lds_byte(wc * 32 + fr, fq * 8);
#define PG8_SA(b, h) (((b) * 2 + (h)) * HTB)
#define PG8_SB(b, h) ((4 + (b) * 2 + (h)) * HTB)
#define PG8_STAGE(bufoff, gbase, voff) do { _Pragma("unroll") for (int _i = 0; _i < 2; ++_i) \
        __builtin_amdgcn_global_load_lds((const unsigned*)((const char*)(gbase) + (voff)[_i]), (LAS unsigned*)(lds + (bufoff) + ldsw + _i * 8192), 16, 0, 0); } while (0)
#define PG8_LDA(dst, b, h) do { _Pragma("unroll") for (int m = 0; m < 4; ++m) _Pragma("unroll") for (int k = 0; k < 2; ++k) dst[m][k] = *(const LAS h16x8*)(lds + PG8_SA(b, h) + aoff + m * 2048 + k * 1024); } while (0)
#define PG8_LDB(dst, b, h) do { _Pragma("unroll") for (int n = 0; n < 2; ++n) _Pragma("unroll") for (int k = 0; k < 2; ++k) dst[n][k] = *(const LAS h16x8*)(lds + PG8_SB(b, h) + boff + n * 2048 + k * 1024); } while (0)
#define PG8_MMA(ai, bj, At, Bt) do { __builtin_amdgcn_s_setprio(1); _Pragma("unroll") for (int m = 0; m < 4; ++m) _Pragma("unroll") for (int n = 0; n < 2; ++n) _Pragma("unroll") for (int k = 0; k < 2; ++k) \
        acc[ai][bj][m][n] = __builtin_amdgcn_mfma_f32_16x16x32_f16(Bt[n][k], At[m][k], acc[ai][bj][m][n], 0, 0, 0); __builtin_amdgcn_s_setprio(0); } while (0)
#define PG8_WAIT_V(n) asm volatile("s_waitcnt vmcnt(" #n ")" ::: "memory")
#define PG8_WAIT_L(n) asm volatile("s_waitcnt lgkmcnt(" #n ")" ::: "memory")
#define PG8_BAR __builtin_amdgcn_s_barrier()
#define PG8_SCHED __builtin_amdgcn_sched_barrier(0)
    Unit cur, nxt; int ui = 0;
    if (!S.next(0, cur)) return;
#ifndef PG8_STAGGER
#define PG8_STAGGER 0
#endif
    if (PG8_STAGGER) {
        Unit t3; if (((blockIdx.x >> 3) & 1) && S.next(2, t3)) { const unsigned long long t0 = __builtin_amdgcn_s_memrealtime(), ticks = (unsigned long long)(nt * 60);
            while (__builtin_amdgcn_s_memrealtime() - t0 < ticks) __builtin_amdgcn_s_sleep(16); } }
    f32x4 acc[2][2][4][2];
#pragma unroll
    for (int a = 0; a < 2; ++a)
#pragma unroll
        for (int b = 0; b < 2; ++b)
#pragma unroll
            for (int m = 0; m < 4; ++m)
#pragma unroll
                for (int n = 0; n < 2; ++n) acc[a][b][m][n] = (f32x4){0.f, 0.f, 0.f, 0.f};
    h16x8 At[4][2], B0[2][2], B1[2][2];
    const char* cA = (const char*)g.A + (size_t)cur.pa * tstep; const char* cB = (const char*)g.Bt + (size_t)cur.pb * tstep;
    PG8_STAGE(PG8_SB(0, 0), cB, voffB); PG8_STAGE(PG8_SB(0, 1), cB + hstep, voffB); PG8_STAGE(PG8_SA(0, 0), cA, voffA); PG8_STAGE(PG8_SA(0, 1), cA + hstep, voffA);
    if (wr == 1) PG8_BAR;
    PG8_WAIT_V(2); PG8_BAR;
    PG8_STAGE(PG8_SB(1, 0), cB + kstep, voffB); PG8_STAGE(PG8_SA(1, 0), cA + kstep, voffA); PG8_STAGE(PG8_SB(1, 1), cB + hstep + kstep, voffB);
    PG8_WAIT_V(6); PG8_BAR;
    for (;;) {
        const bool has_next = S.next(ui + 1, nxt);
        const char* nA = has_next ? (const char*)g.A + (size_t)nxt.pa * tstep : cA; const char* nB = has_next ? (const char*)g.Bt + (size_t)nxt.pb * tstep : cB;
        for (int t = 0; t < nt; t += 2) {
            const bool last = (t == nt - 2);
            const char* a1 = cA + (size_t)(t + 1) * kstep;
            const char* a2 = last ? nA : cA + (size_t)(t + 2) * kstep; const char* b2 = last ? nB : cB + (size_t)(t + 2) * kstep;
            const char* a3 = a2 + kstep; const char* b3 = b2 + kstep;
            PG8_LDB(B0, 0, 0); PG8_LDB(B1, 0, 1); PG8_SCHED; PG8_LDA(At, 0, 0); PG8_STAGE(PG8_SA(1, 1), a1 + hstep, voffA);
            PG8_WAIT_V(8); PG8_WAIT_L(0); PG8_BAR; PG8_MMA(0, 0, At, B0); PG8_MMA(0, 1, At, B1); PG8_BAR; PG8_SCHED;
            PG8_LDA(At, 0, 1); PG8_STAGE(PG8_SB(0, 0), b2, voffB); PG8_STAGE(PG8_SB(0, 1), b2 + hstep, voffB); PG8_STAGE(PG8_SA(0, 0), a2, voffA);
            PG8_WAIT_V(8); PG8_WAIT_L(0); PG8_BAR; PG8_MMA(1, 0, At, B0); PG8_MMA(1, 1, At, B1); PG8_BAR; PG8_SCHED;
            PG8_LDB(B0, 1, 0); PG8_LDB(B1, 1, 1); PG8_SCHED; PG8_LDA(At, 1, 0); PG8_STAGE(PG8_SA(0, 1), a2 + hstep, voffA);
            PG8_WAIT_V(8); PG8_WAIT_L(0); PG8_BAR; PG8_MMA(0, 0, At, B0); PG8_MMA(0, 1, At, B1); PG8_BAR; PG8_SCHED;
            PG8_LDA(At, 1, 1); PG8_STAGE(PG8_SB(1, 0), b3, voffB); PG8_STAGE(PG8_SB(1, 1), b3 + hstep, voffB); PG8_STAGE(PG8_SA(1, 0), a3, voffA);
            PG8_WAIT_V(8); PG8_WAIT_L(0); PG8_BAR; PG8_MMA(1, 0, At, B0); PG8_MMA(1, 1, At, B1); PG8_BAR; PG8_SCHED;
        }
        if constexpr (ALIGN_EPI) { if (wr == 0) PG8_BAR; }
        { int fr_ = fr, fq_ = fq; asm volatile("" : "+v"(fr_), "+v"(fq_)); E(acc, cur, wr, wc, fr_, fq_); }
        if (!has_next) break;
#pragma unroll
        for (int a = 0; a < 2; ++a)
#pragma unroll
            for (int b = 0; b < 2; ++b)
#pragma unroll
                for (int m = 0; m < 4; ++m)
#pragma unroll
                    for (int n = 0; n < 2; ++n) acc[a][b][m][n] = (f32x4){0.f, 0.f, 0.f, 0.f};
        cur = nxt; cA = nA; cB = nB; ++ui;
        if constexpr (ALIGN_EPI) { if (wr == 1) PG8_BAR; }
    }
    PG8_WAIT_V(0);
    if constexpr (!ALIGN_EPI) { if (wr == 0) PG8_BAR; }
    PG8_BAR;
#undef PG8_SA
#undef PG8_SB
#undef PG8_STAGE
#undef PG8_LDA
#undef PG8_LDB
#undef PG8_MMA
#undef PG8_WAIT_V
#undef PG8_WAIT_L
#undef PG8_BAR
#undef PG8_SCHED
}
}

constexpr size_t MiB = 1u << 20;
constexpr size_t WS_CTL = 0, CTL_ZERO_BYTES = 1 * MiB;
constexpr size_t WS_KMEAN = 1 * MiB;
constexpr size_t WS_BIASL = 1 * MiB + 512 * 1024;
constexpr size_t WS_META = 1 * MiB + 768 * 1024;
constexpr size_t WS_ROUTE = 2 * MiB;
constexpr size_t WS_ROWSLOT = 3 * MiB;
constexpr size_t WS_ROPE = 4 * MiB;
constexpr size_t WS_WIN0 = 8 * MiB;
constexpr size_t WS_WOUT0 = 15 * MiB;
constexpr size_t WS_W13_0 = 17 * MiB;
constexpr size_t WS_W2_0 = 28 * MiB;
constexpr size_t WS_WG0 = 34 * MiB, WS_WG1 = 36 * MiB;
constexpr size_t WS_WP0 = 38 * MiB, WS_WP1 = 38 * MiB + 512 * 1024;
constexpr size_t WS_WIN1 = 39 * MiB;
constexpr size_t WS_WOUT1 = 45 * MiB;
constexpr size_t WS_PH = 48 * MiB;
constexpr size_t WS_XA = 80 * MiB, WS_XB = 144 * MiB;
constexpr size_t WS_R = 208 * MiB;
constexpr size_t WS_H = WS_R;
constexpr size_t WS_Y = WS_R;
constexpr size_t WS_MIXIN0 = WS_R + 208 * MiB;
constexpr size_t WS_U0 = WS_R + 272 * MiB, WS_ST0 = WS_R + 304 * MiB, WS_DV0 = WS_R + 336 * MiB;
constexpr size_t WS_LIST = WS_R + 340 * MiB;
constexpr size_t WS_HID = WS_R + 64 * MiB;
constexpr size_t WS_PP = WS_R + 244 * MiB;
constexpr size_t WS_MIXIN1 = WS_R + 192 * MiB;
constexpr size_t WS_U1 = WS_R + 256 * MiB, WS_ST1 = WS_R + 320 * MiB, WS_DV1 = WS_R + 384 * MiB;
constexpr size_t WS_E2 = WS_XB;
constexpr size_t WS_E13 = WS_R;
constexpr size_t WS_XS = WS_R + 112 * MiB;
constexpr size_t WS_HQ = WS_R + 244 * MiB;
constexpr size_t WS_END = 600 * MiB;
static_assert(WS_DV1 + 1 * MiB <= WS_END && WS_HQ + (size_t)MOE_PPP * 256 * FE * 2 <= WS_END && WS_LIST + 16 * MiB <= WS_END, "ws map");
static_assert(WS_HID + (size_t)M * FDP * 2 <= WS_PP && WS_XS + (size_t)MOE_PANELS * 256 * DM * 2 <= WS_HQ, "ws map 2");
constexpr size_t DO_PO = 0, DO_PML = 96 * MiB;

constexpr int CW_BAR = 4096;
constexpr int CW_MOBACNT = 16384;
constexpr int CW_MOECNT = 20480;

constexpr int RING_BYTES = 131072;
constexpr int LDSCTL_OFF = RING_BYTES;
constexpr int LDS_X_OFF = RING_BYTES + 256;
constexpr int LDS_BYTES = 163840;

#define XB_TMO      128
#define XB_XCNT(j)  (256  + 64 * (j))
#define XB_XSUB(j)  (1280 + 64 * (j))
#define XB_XGEN(j)  (2304 + 64 * (j))
#define XB_TOP      3328
#define XB_TOPGEN   3392
#define XCD_BAR_WORDS 3456
#define XB_SPIN_CAP (1u << 18)
__device__ __forceinline__ unsigned xb_ld(unsigned* p)              { return __hip_atomic_load(p, __ATOMIC_RELAXED, __HIP_MEMORY_SCOPE_AGENT); }
__device__ __forceinline__ unsigned xb_add(unsigned* p, unsigned v) { return __hip_atomic_fetch_add(p, v, __ATOMIC_RELAXED, __HIP_MEMORY_SCOPE_AGENT); }
__device__ __forceinline__ unsigned xb_xcc_id() { return (unsigned)__builtin_amdgcn_s_getreg((3 << 11) | 20) & 0xFu; }
#define XB_SPIN(cond, bar) do { unsigned _sp = 0; while (cond) { __builtin_amdgcn_s_sleep(1); \
    if ((++_sp & 255u) == 0u) { if (xb_ld(&(bar)[XB_TMO])) break; if (_sp > XB_SPIN_CAP) { atomicAdd(&(bar)[XB_TMO], 1u); break; } } } } while (0)
struct XcdBarrier { unsigned* bar; unsigned x; volatile LAS unsigned* st; };
__device__ __forceinline__ XcdBarrier xcd_barrier_post(unsigned* bar, volatile LAS unsigned* st) {
    XcdBarrier b; b.bar = bar; b.x = xb_xcc_id(); b.st = st;
    if (threadIdx.x == 0) (void)xb_add(&bar[XB_XCNT(b.x)], 1u);
    return b;
}
__device__ __forceinline__ void xcd_barrier_complete(unsigned* bar, unsigned x, unsigned& nloc, unsigned& nx) {
    const unsigned G = gridDim.x * gridDim.y * gridDim.z;
    unsigned sum, cnt, mine, sp = 0u;
    for (;;) {
        sum = 0u; cnt = 0u; mine = 0u;
#pragma unroll
        for (unsigned j = 0; j < 16; ++j) { const unsigned c = xb_ld(&bar[XB_XCNT(j)]); sum += c; cnt += (c > 0u) ? 1u : 0u; mine = (j == x) ? c : mine; }
        if (sum == G) break;
        __builtin_amdgcn_s_sleep(1);
        if ((++sp & 255u) == 0u) { if (xb_ld(&bar[XB_TMO])) break; if (sp > XB_SPIN_CAP) { atomicAdd(&bar[XB_TMO], 1u); break; } }
    }
    nloc = mine > 0u ? mine : 1u; nx = cnt > 0u ? cnt : 1u;
}
__device__ __forceinline__ void xcd_barrier(const XcdBarrier& b) {
    asm volatile("s_waitcnt vmcnt(0)" ::: "memory");
    __syncthreads();
    if (threadIdx.x == 0) {
        unsigned* bar = b.bar; unsigned bx = b.x; asm volatile("" : "+s"(bar), "+s"(bx));
        __builtin_amdgcn_s_waitcnt(0);
        unsigned nloc = b.st[0], nx = b.st[1];
        if (nloc == 0u) { xcd_barrier_complete(bar, bx, nloc, nx); b.st[0] = nloc; b.st[1] = nx; }
        const unsigned old = xb_add(&bar[XB_XSUB(bx)], 1u);
        const unsigned gen = old / nloc;
        if (old + 1u == (gen + 1u) * nloc) {
            __builtin_amdgcn_fence(__ATOMIC_RELEASE, "agent");
            asm volatile("s_waitcnt vmcnt(0)" ::: "memory");
            const unsigned og = xb_add(&bar[XB_TOP], 1u);
            const unsigned tg = og / nx;
            if (og + 1u == (tg + 1u) * nx) xb_add(&bar[XB_TOPGEN], 1u);
            else XB_SPIN(xb_ld(&bar[XB_TOPGEN]) == tg, bar);
            __builtin_amdgcn_fence(__ATOMIC_ACQUIRE, "agent");
            xb_add(&bar[XB_XGEN(bx)], 1u);
            asm volatile("s_waitcnt vmcnt(0)" ::: "memory");
        } else {
            XB_SPIN(xb_ld(&bar[XB_XGEN(bx)]) == gen, bar);
            __builtin_amdgcn_fence(__ATOMIC_ACQUIRE, "agent");
            asm volatile("s_waitcnt vmcnt(0)" ::: "memory");
        }
    }
    __syncthreads();
}

struct Args { const float* in[27]; float* out; unsigned char* ws; int ph_lo, ph_hi; };
enum InIdx { I_X = 0, I_P, I_RELB, I_EWIN, I_GLAWG, I_GLABG, I_GLAN, I_EWOUT, I_OWIN, I_HGAMMA, I_HNORM, I_RNORM, I_OWOUT, I_LMG, I_LMB, I_LFG, I_LFB,
             I_FW1, I_FW3, I_FW2, I_RW, I_RB, I_XW1, I_XW3, I_XW2, I_PWG, I_PWP };
struct Frame {
    LAS unsigned char* lds; int tid, lane, wave, vcu, G; unsigned char* ws; gu32* ctl; const Args* a;
};
__device__ __forceinline__ void launder(Frame& F) {
    int t = threadIdx.x; asm volatile("" : "+v"(t)); F.tid = t; F.lane = t & 63; F.wave = __builtin_amdgcn_readfirstlane(t >> 6);
    unsigned char* w = F.ws; asm volatile("" : "+s"(w)); F.ws = w; F.ctl = (gu32*)(w + WS_CTL);
    int v = F.vcu, g = F.G; asm volatile("" : "+s"(v), "+s"(g)); F.vcu = v; F.G = g;
}
__device__ __forceinline__ float wave_sum(float v) {
#pragma unroll
    for (int o = 1; o < 64; o <<= 1) v += __shfl_xor(v, o);
    return v;
}

__device__ __forceinline__ int rowmap(int mode, int n) {
    if (mode == 0) return n;
    if (mode == 1) return n < 2560 ? n : (n < 2576 ? 3072 + (n - 2560) : 2560 + (n - 2576));
    if (mode == 2) return (n >> 7) * 256 + (n & 127);
    return (n >> 7) * 256 + 128 + (n & 127);
}
__device__ __forceinline__ void transpose_item(const float* W, int N, h16* WT, int ldk, int mode, LAS float* scr, int item, int lane) {
    const int nblk = (N + 31) / 32, kb = item / nblk, nb = item % nblk, k0 = 64 * kb, n0 = 32 * nb;
    const int nn = n0 + (lane & 31); const bool ok = nn < N;
    float tv[32];
#pragma unroll
    for (int i = 0; i < 32; ++i) { const int kk = 2 * i + (lane >> 5); tv[i] = ok ? W[(size_t)(k0 + kk) * N + nn] : 0.f; }
#pragma unroll
    for (int i = 0; i < 32; ++i) { const int kk = 2 * i + (lane >> 5); scr[kk * 33 + (lane & 31)] = tv[i]; }
    LDS_WAIT(); asm volatile("" ::: "memory");
    const int c = lane & 7;
#pragma unroll
    for (int j = 0; j < 4; ++j) { const int n = (lane >> 3) + 8 * j; const LAS float* s = scr + (8 * c) * 33 + n;
        if (n0 + n < N) { h16x8 o;
#pragma unroll
            for (int q = 0; q < 8; ++q) o[q] = (h16)s[q * 33];
            *(h16x8*)(WT + (size_t)rowmap(mode, n0 + n) * ldk + k0 + 8 * c) = o; } }
    LDS_WAIT(); asm volatile("" ::: "memory");
}
struct TDesc { const float* W; int K, N; h16* WT; int ldk, mode; };
__device__ __forceinline__ int titems(const TDesc& d) { return (d.K / 64) * ((d.N + 31) / 32); }

__device__ __forceinline__ void zero16(void* p) { *(u32x4*)p = (u32x4){0u, 0u, 0u, 0u}; }
__device__ __forceinline__ void cvt8(const float* src, h16* dst) { const f32x4 a = *(const f32x4*)src, b = *(const f32x4*)(src + 4); *(h16x8*)dst = pg8::pack8(a, b); }
__device__ __forceinline__ void cvt_stream(const float* src, h16* dst, size_t nchunk, size_t gt, size_t NGT) {
    size_t i = gt;
    for (; i + 3 * NGT < nchunk; i += 4 * NGT) { f32x4 a[4], b[4];
#pragma unroll
        for (int j = 0; j < 4; ++j) { a[j] = *(const f32x4*)(src + (i + j * NGT) * 8); b[j] = *(const f32x4*)(src + (i + j * NGT) * 8 + 4); }
#pragma unroll
        for (int j = 0; j < 4; ++j) *(h16x8*)(dst + (i + j * NGT) * 8) = pg8::pack8(a[j], b[j]); }
    for (; i < nchunk; i += NGT) cvt8(src + i * 8, dst + i * 8);
}
__device__ __forceinline__ int t5_bucket(int n) {
    if (n < 16) return n < 0 ? 0 : n;
    int b = 16;
    b += (n >= 19) + (n >= 21) + (n >= 24) + (n >= 27) + (n >= 31) + (n >= 35) + (n >= 40) + (n >= 46) + (n >= 52) + (n >= 59) + (n >= 67) + (n >= 77) + (n >= 87) + (n >= 99) + (n >= 113);
    return b;
}
__device__ __forceinline__ void p_prologue(Frame& F) {
    const Args& A = *F.a; unsigned char* ws = F.ws;
    LAS float* scr = (LAS float*)(F.lds + F.wave * 16384);
    const int gw = F.vcu * NWAVES + F.wave, NGW = F.G * NWAVES;
    constexpr int T0 = 16 * 97, T1 = 16 * 32, T2 = 16 * 86, T3 = T2, T4 = 43 * 32, T5 = 16 * 32, T6 = T5, T7 = 4 * 32, T8 = T7, T9 = 16 * 96, T10 = 16 * 32;
    constexpr int NT = T0 + T1 + T2 + T3 + T4 + T5 + T6 + T7 + T8 + T9 + T10;
    for (int it = gw; it < NT; it += NGW) {
        int r = it;
        if (r < T0) { transpose_item(A.in[I_EWIN], 3088, (h16*)(ws + WS_WIN0), 1024, 1, scr, r, F.lane); continue; } r -= T0;
        if (r < T1) { transpose_item(A.in[I_EWOUT], 1024, (h16*)(ws + WS_WOUT0), 1024, 0, scr, r, F.lane); continue; } r -= T1;
        if (r < T2) { transpose_item(A.in[I_FW1], FD, (h16*)(ws + WS_W13_0), 1024, 2, scr, r, F.lane); continue; } r -= T2;
        if (r < T3) { transpose_item(A.in[I_FW3], FD, (h16*)(ws + WS_W13_0), 1024, 3, scr, r, F.lane); continue; } r -= T3;
        if (r < T4) { transpose_item(A.in[I_FW2], 1024, (h16*)(ws + WS_W2_0), FDP, 0, scr, r, F.lane); continue; } r -= T4;
        if (r < T5) { transpose_item(A.in[I_PWG], 1024, (h16*)(ws + WS_WG0), 1024, 0, scr, r, F.lane); continue; } r -= T5;
        if (r < T6) { transpose_item(A.in[I_PWG] + 1024 * 1024, 1024, (h16*)(ws + WS_WG1), 1024, 0, scr, r, F.lane); continue; } r -= T6;
        if (r < T7) { transpose_item(A.in[I_PWP], 1024, (h16*)(ws + WS_WP0), 256, 0, scr, r, F.lane); continue; } r -= T7;
        if (r < T8) { transpose_item(A.in[I_PWP] + 256 * 1024, 1024, (h16*)(ws + WS_WP1), 256, 0, scr, r, F.lane); continue; } r -= T8;
        if (r < T9) { transpose_item(A.in[I_OWIN], N1, (h16*)(ws + WS_WIN1), 1024, 0, scr, r, F.lane); continue; } r -= T9;
        transpose_item(A.in[I_OWOUT], 1024, (h16*)(ws + WS_WOUT1), 1024, 0, scr, r, F.lane);
    }
    const size_t gt = (size_t)F.vcu * NTHR + F.tid, NGT = (size_t)F.G * NTHR;
    { h16* w = (h16*)(ws + WS_WIN0) + (size_t)3088 * 1024; for (size_t i = gt; i < 30720; i += NGT) zero16(w + i * 8); }
    { h16* w = (h16*)(ws + WS_W13_0); for (size_t i = gt; i < 128 * 128; i += NGT) { const int rr = (int)(i >> 7), ch = (int)(i & 127); const int row = 21 * 256 + (rr < 64 ? 64 + rr : 128 + 64 + (rr - 64)); zero16(w + (size_t)row * 1024 + ch * 8); } }
    { h16* w = (h16*)(ws + WS_W2_0); for (size_t i = gt; i < 1024 * 8; i += NGT) { const int row = (int)(i >> 3), ch = (int)(i & 7); zero16(w + (size_t)row * FDP + FD + ch * 8); } }
    { const float* x = A.in[I_X]; h16* xa = (h16*)(ws + WS_XA); cvt_stream(x, xa, (size_t)M * DM / 8, gt, NGT); }
    { const float* p = A.in[I_P]; h16* ph = (h16*)(ws + WS_PH); cvt_stream(p, ph, (size_t)2 * M * PLE / 8, gt, NGT); }
    { float* rc = (float*)(ws + WS_ROPE); float* rs = rc + SEQ * 32;
      for (size_t i = gt; i < (size_t)SEQ * 32; i += NGT) { const int t = (int)(i >> 5), k = (int)(i & 31); const float inv = (float)pow(10000.0, -(double)k / 32.0); const float ang = (float)t * inv;
          rc[i] = (float)cos((double)ang); rs[i] = (float)sin((double)ang); } }
    { float* bl = (float*)(ws + WS_BIASL); const float* rb = A.in[I_RELB]; for (size_t i = gt; i < 8 * 128; i += NGT) { const int h = (int)(i >> 7), d = (int)(i & 127); bl[i] = rb[t5_bucket(d) * 8 + h]; } }
}

template <int MODE>
__device__ __forceinline__ void ln_phase(Frame& F, const h16* Y, const float* gam, const float* bet, h16* Xout, const h16* XR, const h16* ys) {
    const Args& A = *F.a;
    LAS float* wr_l = (LAS float*)F.lds;
    LAS int* rt_l = (LAS int*)(F.lds + 32768);
    LAS float* rg_l = (LAS float*)(F.lds + 32768 + 2048);
    LAS int* lcnt = (LAS int*)(F.lds + 32768 + 4096);
    int* route = (int*)(F.ws + WS_ROUTE);
    if (MODE == 1) { const float* rw = A.in[I_RW]; for (int i = F.tid; i < 8192; i += NTHR) wr_l[i] = rw[i]; }
    f32x4 g4[4], b4[4];
#pragma unroll
    for (int j = 0; j < 2; ++j) { const int c = j * 512 + F.lane * 8; g4[2 * j] = *(const f32x4*)(gam + c); g4[2 * j + 1] = *(const f32x4*)(gam + c + 4); b4[2 * j] = *(const f32x4*)(bet + c); b4[2 * j + 1] = *(const f32x4*)(bet + c + 4); }
    for (int rb = F.vcu * 128; rb < M; rb += F.G * 128) {
        if (MODE == 1) { if (F.tid < 16) lcnt[F.tid] = 0; __syncthreads(); }
        h16x8 ynext[2];
        if (MODE != 2) {
#pragma unroll
            for (int j = 0; j < 2; ++j) ynext[j] = *(const h16x8*)(Y + (size_t)(rb + F.wave * 16) * DM + j * 512 + F.lane * 8); }
        for (int i = 0; i < 16; ++i) {
            const int row = rb + F.wave * 16 + i;
            float v[16];
            h16x8 ycur[2];
            if (MODE != 2) { ycur[0] = ynext[0]; ycur[1] = ynext[1]; const int rn = i < 15 ? row + 1 : row;
#pragma unroll
                for (int j = 0; j < 2; ++j) ynext[j] = *(const h16x8*)(Y + (size_t)rn * DM + j * 512 + F.lane * 8); }
            if (MODE == 2) {
                const int* rr = route + (size_t)row * 8; const float g0 = __int_as_float(rr[4]), g1 = __int_as_float(rr[5]);
#pragma unroll
                for (int j = 0; j < 2; ++j) { const int c = j * 512 + F.lane * 8; const h16x8 xr = *(const h16x8*)(XR + (size_t)row * DM + c), y0 = *(const h16x8*)(ys + (size_t)(2 * row) * DM + c), y1 = *(const h16x8*)(ys + (size_t)(2 * row + 1) * DM + c);
#pragma unroll
                    for (int q = 0; q < 8; ++q) v[8 * j + q] = DN_ALPHA * (float)xr[q] + g0 * (float)y0[q] + g1 * (float)y1[q]; }
            } else {
#pragma unroll
                for (int j = 0; j < 2; ++j) { const h16x8 y = ycur[j];
#pragma unroll
                    for (int q = 0; q < 8; ++q) v[8 * j + q] = (float)y[q]; }
            }
            float s = 0.f;
#pragma unroll
            for (int q = 0; q < 16; ++q) s += v[q];
            const float mean = wave_sum(s) * (1.f / DM); float s2 = 0.f;
#pragma unroll
            for (int q = 0; q < 16; ++q) { v[q] -= mean; s2 += v[q] * v[q]; }
            const float rstd = 1.f / sqrtf(wave_sum(s2) * (1.f / DM) + LN_EPS);
#pragma unroll
            for (int q = 0; q < 16; ++q) v[q] = v[q] * rstd * g4[q >> 2][q & 3] + b4[q >> 2][q & 3];
#pragma unroll
            for (int j = 0; j < 2; ++j) { h16x8 o;
#pragma unroll
                for (int q = 0; q < 8; ++q) o[q] = (h16)v[8 * j + q];
                *(h16x8*)(Xout + (size_t)row * DM + j * 512 + F.lane * 8) = o; }
            if (MODE == 1) {
                float lg[8];
#pragma unroll
                for (int e = 0; e < 8; ++e) lg[e] = 0.f;
#pragma unroll
                for (int j = 0; j < 2; ++j)
#pragma unroll
                    for (int q = 0; q < 8; ++q) { const int c = j * 512 + F.lane * 8 + q; const f32x4 w0 = *(const LAS f32x4*)(wr_l + c * 8), w1 = *(const LAS f32x4*)(wr_l + c * 8 + 4); const float x = v[8 * j + q];
                        lg[0] += x * w0[0]; lg[1] += x * w0[1]; lg[2] += x * w0[2]; lg[3] += x * w0[3]; lg[4] += x * w1[0]; lg[5] += x * w1[1]; lg[6] += x * w1[2]; lg[7] += x * w1[3]; }
#pragma unroll
                for (int e = 0; e < 8; ++e) lg[e] = wave_sum(lg[e]) + A.in[I_RB][e];
                if (F.lane == 0) {
                    int e0 = 0; float m0 = lg[0];
#pragma unroll
                    for (int e = 1; e < 8; ++e) if (lg[e] > m0) { m0 = lg[e]; e0 = e; }
                    int e1 = -1; float m1 = -INFINITY;
#pragma unroll
                    for (int e = 0; e < 8; ++e) if (e != e0 && lg[e] > m1) { m1 = lg[e]; e1 = e; }
                    const float g0 = 1.f / (1.f + expf(m1 - m0));
                    const int s0 = atomicAdd((int*)&lcnt[e0], 1), s1 = atomicAdd((int*)&lcnt[e1], 1);
                    const int li = F.wave * 16 + i;
                    rt_l[li * 4 + 0] = e0; rt_l[li * 4 + 1] = s0; rt_l[li * 4 + 2] = e1; rt_l[li * 4 + 3] = s1; rg_l[li * 2] = g0; rg_l[li * 2 + 1] = 1.f - g0;
                }
            }
        }
        if (MODE == 1) {
            __syncthreads();
            if (F.tid < 8) lcnt[8 + F.tid] = (int)__hip_atomic_fetch_add(F.ctl + CW_MOECNT + F.tid, (unsigned)lcnt[F.tid], RLX_AGENT);
            __syncthreads();
            if (F.tid < 128) { const int row = rb + F.tid; int* rr = route + (size_t)row * 8; const int e0 = rt_l[F.tid * 4], e1 = rt_l[F.tid * 4 + 2];
                rr[0] = e0; rr[1] = lcnt[8 + e0] + rt_l[F.tid * 4 + 1]; rr[2] = e1; rr[3] = lcnt[8 + e1] + rt_l[F.tid * 4 + 3]; rr[4] = __float_as_int(rg_l[F.tid * 2]); rr[5] = __float_as_int(rg_l[F.tid * 2 + 1]); }
            __syncthreads();
        }
    }
}

constexpr int KL_STRIDE = 72, VT_STRIDE = 264;
constexpr int LIST_PER_BH = 516096;
__device__ __forceinline__ int moba_binoff(int j) { return 256 * (63 * j - (j * (j - 1)) / 2); }

__device__ __forceinline__ void moba_kmean_unit(Frame& F, int u) {
    const int b = u >> 6, blk = u & 63; const h16* Hh = (const h16*)(F.ws + WS_H);
    const h16* p = Hh + (size_t)(b * SEQ + blk * 256) * N0 + C0_MK + F.tid;
    float s = 0.f;
#pragma unroll 8
    for (int r = 0; r < 256; ++r) s += (float)p[(size_t)r * N0];
    float* km = (float*)(F.ws + WS_KMEAN);
    km[((size_t)(b * 8 + (F.tid >> 6)) * 64 + blk) * 64 + (F.tid & 63)] = s * (1.f / 256.f);
}

__device__ __forceinline__ bool better(float av, int ai, float bv, int bi) { return av > bv || (av == bv && ai < bi); }
__device__ __forceinline__ void top3_insert(float g, int n, float& v0, int& i0, float& v1, int& i1, float& v2, int& i2) {
    const bool b2 = better(g, n, v2, i2), b1 = better(g, n, v1, i1), b0 = better(g, n, v0, i0);
    const float nv2 = b1 ? v1 : (b2 ? g : v2); const int ni2 = b1 ? i1 : (b2 ? n : i2);
    const float nv1 = b0 ? v0 : (b1 ? g : v1); const int ni1 = b0 ? i0 : (b1 ? n : i1);
    const float nv0 = b0 ? g : v0; const int ni0 = b0 ? n : i0;
    v0 = nv0; i0 = ni0; v1 = nv1; i1 = ni1; v2 = nv2; i2 = ni2;
}
__device__ __forceinline__ void moba_select_unit(Frame& F, int u) {
    const int bh = u / 63, c = 1 + u % 63, b = bh >> 3, h = bh & 7;
    LAS float* km = (LAS float*)F.lds; LAS int* hist = (LAS int*)(F.lds + 16384); LAS int* gbase = hist + 64;
    const float* kmg = (const float*)(F.ws + WS_KMEAN) + (size_t)bh * 64 * 64;
    __syncthreads();
    for (int i = F.tid; i < c * 64; i += NTHR) km[i] = kmg[i];
    if (F.tid < 64) hist[F.tid] = 0;
    const int q = F.tid >> 1, half = F.tid & 1;
    const h16* Hh = (const h16*)(F.ws + WS_H);
    const h16* qp = Hh + (size_t)(b * SEQ + c * 256 + q) * N0 + C0_MQ + h * 64;
    float qv[64];
#pragma unroll
    for (int j = 0; j < 8; ++j) { const h16x8 t = *(const h16x8*)(qp + 8 * j);
#pragma unroll
        for (int k = 0; k < 8; ++k) qv[8 * j + k] = (float)t[k]; }
    __syncthreads();
    float v0 = -INFINITY, v1 = -INFINITY, v2 = -INFINITY; int i0 = 1000, i1 = 1001, i2 = 1002;
    for (int n = half; n < c; n += 2) {
        const LAS f32x4* kr = (const LAS f32x4*)(km + n * 64); float g = 0.f;
#pragma unroll
        for (int j = 0; j < 16; ++j) { const f32x4 kk = kr[j]; g += qv[4 * j] * kk[0] + qv[4 * j + 1] * kk[1] + qv[4 * j + 2] * kk[2] + qv[4 * j + 3] * kk[3]; }
        top3_insert(g, n, v0, i0, v1, i1, v2, i2);
    }
    { const float pv0 = __shfl_xor(v0, 1), pv1 = __shfl_xor(v1, 1), pv2 = __shfl_xor(v2, 1); const int pi0 = __shfl_xor(i0, 1), pi1 = __shfl_xor(i1, 1), pi2 = __shfl_xor(i2, 1);
      top3_insert(pv0, pi0, v0, i0, v1, i1, v2, i2); top3_insert(pv1, pi1, v0, i0, v1, i1, v2, i2); top3_insert(pv2, pi2, v0, i0, v1, i1, v2, i2); }
    const int nvalid = c < 3 ? c : 3;
    int pos0 = 0, pos1 = 0, pos2 = 0;
    if (half == 0) { pos0 = atomicAdd((int*)&hist[i0], 1); if (nvalid > 1) pos1 = atomicAdd((int*)&hist[i1], 1); if (nvalid > 2) pos2 = atomicAdd((int*)&hist[i2], 1); }
    __syncthreads();
    if (F.tid < c) { const int n = hist[F.tid]; gbase[F.tid] = n ? (int)__hip_atomic_fetch_add(F.ctl + CW_MOBACNT + bh * 64 + F.tid, (unsigned)n, RLX_AGENT) : 0; }
    __syncthreads();
    if (half == 0) {
        unsigned short* list = (unsigned short*)(F.ws + WS_LIST) + (size_t)bh * LIST_PER_BH; const int t = c * 256 + q;
        list[moba_binoff(i0) + gbase[i0] + pos0] = (unsigned short)(t | (0 << 14));
        if (nvalid > 1) list[moba_binoff(i1) + gbase[i1] + pos1] = (unsigned short)(t | (1 << 14));
        if (nvalid > 2) list[moba_binoff(i2) + gbase[i2] + pos2] = (unsigned short)(t | (2 << 14));
    }
}

__device__ __forceinline__ void moba_stage(Frame& F, int b, int h, int j, LAS h16* K_l, LAS h16* VT_l, LAS float* BL_l) {
    const h16* Hh = (const h16*)(F.ws + WS_H);
    const h16* kb = Hh + (size_t)(b * SEQ + j * 256) * N0 + C0_MK + h * 64;
    const h16* vb = Hh + (size_t)(b * SEQ + j * 256) * N0 + C0_MV + h * 64;
#pragma unroll
    for (int i = 0; i < 4; ++i) { const int id = F.tid + i * NTHR, r = id >> 3, ch = id & 7;
        const h16x8 kv = *(const h16x8*)(kb + (size_t)r * N0 + ch * 8); *(LAS h16x8*)(K_l + r * KL_STRIDE + ch * 8) = kv;
        const h16x8 vv = *(const h16x8*)(vb + (size_t)r * N0 + ch * 8);
#pragma unroll
        for (int k = 0; k < 8; ++k) VT_l[(ch * 8 + k) * VT_STRIDE + (r ^ (ch << 2))] = vv[k]; }
    if (F.tid < 128) BL_l[F.tid] = ((const float*)(F.ws + WS_BIASL))[h * 128 + F.tid];
}

__device__ __forceinline__ void block_scan_1024(Frame& F, int a, int b, LAS int* out, LAS int* wsum) {
    int s = a + b, inc = s;
#pragma unroll
    for (int o = 1; o < 64; o <<= 1) { const int t = __shfl_up(inc, o); if (F.lane >= o) inc += t; }
    if (F.lane == 63) wsum[F.wave] = inc;
    __syncthreads();
    int base = 0;
    for (int w = 0; w < F.wave; ++w) base += wsum[w];
    const int ex = base + inc - s;
    out[2 * F.tid] = ex; out[2 * F.tid + 1] = ex + a;
    if (F.tid == NTHR - 1) out[1024] = ex + s;
    __syncthreads();
}

__device__ __forceinline__ void moba_sparse_phase(Frame& F) {
    LAS h16* K_l = (LAS h16*)F.lds; LAS h16* VT_l = (LAS h16*)(F.lds + 36864); LAS float* BL_l = (LAS float*)(F.lds + 70656);
    LAS int* pfx = (LAS int*)(F.lds + 71680); LAS int* wsum = (LAS int*)(F.lds + 71680 + 4224);
    const gu32* cnts = F.ctl + CW_MOBACNT;
    int pa, pb; { const int b0 = 2 * F.tid, b1 = b0 + 1;
        pa = b0 < 1008 ? (int)((__hip_atomic_load(cnts + (b0 / 63) * 64 + b0 % 63, RLX_AGENT) + 511u) >> 9) : 0;
        pb = b1 < 1008 ? (int)((__hip_atomic_load(cnts + (b1 / 63) * 64 + b1 % 63, RLX_AGENT) + 511u) >> 9) : 0; }
    __syncthreads();
    block_scan_1024(F, pa, pb, pfx, wsum);
    const int NI = pfx[1008];
    const int k0 = (int)((long)F.vcu * NI / F.G), k1 = (int)((long)(F.vcu + 1) * NI / F.G);
    const h16* Hh = (const h16*)(F.ws + WS_H);
    h16* PO = (h16*)((unsigned char*)F.a->out + DO_PO); float* PML = (float*)((unsigned char*)F.a->out + DO_PML);
    int pbin = -1;
    const int q = F.lane & 15, fq = F.lane >> 4;
    for (int k = k0; k < k1; ++k) {
        int lo = 0, hi = 1007;
        while (lo < hi) { const int mid = (lo + hi + 1) >> 1; if (pfx[mid] <= k) lo = mid; else hi = mid - 1; }
        const int bin = lo, part = k - pfx[bin], bh = bin / 63, j = bin % 63, b = bh >> 3, h = bh & 7;
        if (bin != pbin) { __syncthreads(); moba_stage(F, b, h, j, K_l, VT_l, BL_l); pbin = bin; __syncthreads(); }
        const int cnt = (int)__hip_atomic_load(cnts + bh * 64 + j, RLX_AGENT);
        const unsigned short* list = (const unsigned short*)(F.ws + WS_LIST) + (size_t)bh * LIST_PER_BH + moba_binoff(j);
        const int nq = (cnt - part * 512) < 512 ? (cnt - part * 512) : 512, ntile = (nq + 15) >> 4;
        for (int tile = F.wave; tile < ntile; tile += NWAVES) {
            const int idx = part * 512 + tile * 16 + q; const bool valid = idx < cnt;
            const int entry = valid ? (int)list[idx] : ((j + 1) * 256);
            const int tq = entry & 0x3fff;
            const h16* qp = Hh + (size_t)(b * SEQ + tq) * N0 + C0_MQ + h * 64 + 8 * fq;
            const h16x8 qf0 = *(const h16x8*)qp, qf1 = *(const h16x8*)(qp + 32);
            f32x4 s[16];
#pragma unroll
            for (int kt = 0; kt < 16; ++kt) { const LAS h16* kp = K_l + (16 * kt + q) * KL_STRIDE + 8 * fq;
                f32x4 a = (f32x4){0.f, 0.f, 0.f, 0.f};
                a = __builtin_amdgcn_mfma_f32_16x16x32_f16(*(const LAS h16x8*)kp, qf0, a, 0, 0, 0);
                a = __builtin_amdgcn_mfma_f32_16x16x32_f16(*(const LAS h16x8*)(kp + 32), qf1, a, 0, 0, 0); s[kt] = a;
                if ((kt & 3) == 3) __builtin_amdgcn_sched_barrier(0); }
            const int dmin = tq - (256 * j + 255);
            float mx = -INFINITY;
            if (__all(dmin >= 113)) { const float bc = BL_l[127];
#pragma unroll
                for (int kt = 0; kt < 16; ++kt)
#pragma unroll
                    for (int r = 0; r < 4; ++r) { s[kt][r] = s[kt][r] * 0.125f + bc; mx = fmaxf(mx, s[kt][r]); }
            } else {
#pragma unroll
                for (int kt = 0; kt < 16; ++kt)
#pragma unroll
                    for (int r = 0; r < 4; ++r) { int d = tq - (256 * j + 16 * kt + 4 * fq + r); d = d > 127 ? 127 : (d < 0 ? 0 : d); s[kt][r] = s[kt][r] * 0.125f + BL_l[d]; mx = fmaxf(mx, s[kt][r]); }
            }
            mx = fmaxf(mx, __shfl_xor(mx, 16)); mx = fmaxf(mx, __shfl_xor(mx, 32));
            float l = 0.f; h16x8 pf[8];
#pragma unroll
            for (int ks = 0; ks < 8; ++ks) {
#pragma unroll
                for (int r = 0; r < 4; ++r) { const float p0 = __expf(s[2 * ks][r] - mx), p1 = __expf(s[2 * ks + 1][r] - mx); l += p0 + p1; pf[ks][r] = (h16)p0; pf[ks][4 + r] = (h16)p1; } }
            l += __shfl_xor(l, 16); l += __shfl_xor(l, 32);
            f32x4 o[4];
#pragma unroll
            for (int dt = 0; dt < 4; ++dt) { o[dt] = (f32x4){0.f, 0.f, 0.f, 0.f}; const LAS h16* vp = VT_l + (16 * dt + q) * VT_STRIDE; const int vsw = (((16 * dt + q) >> 3) & 7) << 2;
#pragma unroll
                for (int ks = 0; ks < 8; ++ks) { const h16x4 lo4 = *(const LAS h16x4*)(vp + ((32 * ks + 4 * fq) ^ vsw)), hi4 = *(const LAS h16x4*)(vp + ((32 * ks + 16 + 4 * fq) ^ vsw));
                    h16x8 vf; vf[0] = lo4[0]; vf[1] = lo4[1]; vf[2] = lo4[2]; vf[3] = lo4[3]; vf[4] = hi4[0]; vf[5] = hi4[1]; vf[6] = hi4[2]; vf[7] = hi4[3];
                    o[dt] = __builtin_amdgcn_mfma_f32_16x16x32_f16(pf[ks], vf, o[dt], 0, 0, 0); } }
            const int ev = valid ? entry : -1;
#pragma unroll
            for (int r = 0; r < 4; ++r) { const int e2 = __shfl(ev, 4 * fq + r);
                if (e2 >= 0) { const size_t base = (((size_t)(b * SEQ + (e2 & 0x3fff)) * 8 + h) * 3 + (e2 >> 14)) * 64 + q;
#pragma unroll
                    for (int dt = 0; dt < 4; ++dt) PO[base + 16 * dt] = (h16)o[dt][r]; } }
            if (fq == 0 && valid) { const size_t mi = (((size_t)(b * SEQ + tq) * 8 + h) * 3 + (entry >> 14)) * 2; *(f32x2*)(PML + mi) = (f32x2){mx, l}; }
        }
    }
}

__device__ __forceinline__ void moba_own_unit(Frame& F, int u) {
    const int bh = u >> 6, c = u & 63, b = bh >> 3, h = bh & 7;
    LAS h16* K_l = (LAS h16*)F.lds; LAS h16* VT_l = (LAS h16*)(F.lds + 36864); LAS float* BL_l = (LAS float*)(F.lds + 70656);
    __syncthreads(); moba_stage(F, b, h, c, K_l, VT_l, BL_l); __syncthreads();
    const h16* Hh = (const h16*)(F.ws + WS_H);
    const h16* PO = (const h16*)((unsigned char*)F.a->out + DO_PO); const float* PML = (const float*)((unsigned char*)F.a->out + DO_PML);
    h16* MX = (h16*)(F.ws + WS_MIXIN0);
    const int q = F.lane & 15, fq = F.lane >> 4; const int nvalid = c < 3 ? c : 3;
#pragma unroll 1
    for (int s2 = 0; s2 < 2; ++s2) {
        const int ti = s2 == 0 ? F.wave : 15 - F.wave;
        const int tl = 16 * ti + q; const size_t row = (size_t)b * SEQ + c * 256 + tl;
        const h16* qp = Hh + row * N0 + C0_MQ + h * 64 + 8 * fq;
        const h16x8 qf0 = *(const h16x8*)qp, qf1 = *(const h16x8*)(qp + 32);
        f32x4 s[16]; float mx = -INFINITY;
#pragma unroll
        for (int kt = 0; kt < 16; ++kt) {
            if (kt <= ti) { const LAS h16* kp = K_l + (16 * kt + q) * KL_STRIDE + 8 * fq;
                f32x4 a = (f32x4){0.f, 0.f, 0.f, 0.f};
                a = __builtin_amdgcn_mfma_f32_16x16x32_f16(*(const LAS h16x8*)kp, qf0, a, 0, 0, 0);
                a = __builtin_amdgcn_mfma_f32_16x16x32_f16(*(const LAS h16x8*)(kp + 32), qf1, a, 0, 0, 0);
#pragma unroll
                for (int r = 0; r < 4; ++r) { const int d = tl - (16 * kt + 4 * fq + r); const float v = a[r] * 0.125f + BL_l[d > 127 ? 127 : (d < 0 ? 0 : d)]; a[r] = d >= 0 ? v : -INFINITY; mx = fmaxf(mx, a[r]); }
                s[kt] = a;
            } else s[kt] = (f32x4){-INFINITY, -INFINITY, -INFINITY, -INFINITY};
            if ((kt & 3) == 3) __builtin_amdgcn_sched_barrier(0);
        }
        mx = fmaxf(mx, __shfl_xor(mx, 16)); mx = fmaxf(mx, __shfl_xor(mx, 32));
        float l = 0.f; h16x8 pf[8];
#pragma unroll
        for (int ks = 0; ks < 8; ++ks) {
#pragma unroll
            for (int r = 0; r < 4; ++r) { const float p0 = __expf(s[2 * ks][r] - mx), p1 = __expf(s[2 * ks + 1][r] - mx); l += p0 + p1; pf[ks][r] = (h16)p0; pf[ks][4 + r] = (h16)p1; } }
        l += __shfl_xor(l, 16); l += __shfl_xor(l, 32);
        f32x4 o[4];
#pragma unroll
        for (int dt = 0; dt < 4; ++dt) { o[dt] = (f32x4){0.f, 0.f, 0.f, 0.f}; const LAS h16* vp = VT_l + (16 * dt + q) * VT_STRIDE; const int vsw = (((16 * dt + q) >> 3) & 7) << 2;
#pragma unroll
            for (int ks = 0; ks < 8; ++ks) { if (2 * ks <= ti) { const h16x4 lo4 = *(const LAS h16x4*)(vp + ((32 * ks + 4 * fq) ^ vsw)), hi4 = *(const LAS h16x4*)(vp + ((32 * ks + 16 + 4 * fq) ^ vsw));
                h16x8 vf; vf[0] = lo4[0]; vf[1] = lo4[1]; vf[2] = lo4[2]; vf[3] = lo4[3]; vf[4] = hi4[0]; vf[5] = hi4[1]; vf[6] = hi4[2]; vf[7] = hi4[3];
                o[dt] = __builtin_amdgcn_mfma_f32_16x16x32_f16(pf[ks], vf, o[dt], 0, 0, 0); } } }
        float mr[3], lr[3]; float Mx = mx;
#pragma unroll
        for (int k = 0; k < 3; ++k) { if (k < nvalid) { const f32x2 t = *(const f32x2*)(PML + ((row * 8 + h) * 3 + k) * 2); mr[k] = t[0]; lr[k] = t[1]; Mx = fmaxf(Mx, mr[k]); } else { mr[k] = -INFINITY; lr[k] = 0.f; } }
        const float wo = __expf(mx - Mx); float den = l * wo; float wk[3];
#pragma unroll
        for (int k = 0; k < 3; ++k) { wk[k] = k < nvalid ? __expf(mr[k] - Mx) : 0.f; den += lr[k] * wk[k]; }
        const float inv = 1.f / den;
#pragma unroll
        for (int r = 0; r < 4; ++r) { const int q2 = 4 * fq + r; const float wo2 = __shfl(wo, q2) , inv2 = __shfl(inv, q2); const float w0 = __shfl(wk[0], q2), w1 = __shfl(wk[1], q2), w2 = __shfl(wk[2], q2);
            const size_t row2 = (size_t)b * SEQ + c * 256 + 16 * ti + q2; const h16* pp = PO + ((row2 * 8 + h) * 3) * 64 + q;
#pragma unroll
            for (int dt = 0; dt < 4; ++dt) { float v = o[dt][r] * wo2;
                if (nvalid > 0) v += (float)pp[16 * dt] * w0;
                if (nvalid > 1) v += (float)pp[64 + 16 * dt] * w1;
                if (nvalid > 2) v += (float)pp[128 + 16 * dt] * w2;
                MX[row2 * DM + h * 64 + 16 * dt + q] = (h16)(v * inv2); }
            asm volatile("" ::: "memory"); }
    }
}

constexpr int GS = 72;
constexpr int GO = 136;
template <int MIX> struct GlaCfg;
template <> struct GlaCfg<0> { static constexpr int PITCH = N0, CQ = C0_GQ, CK = C0_GK, CV = C0_GV, CG = C0_GR, OUTC = 512; };
template <> struct GlaCfg<1> { static constexpr int PITCH = N1, CQ = C1_HQ, CK = C1_HF, CV = C1_HI, CG = C1_HG, OUTC = 0; };
template <> struct GlaCfg<2> { static constexpr int PITCH = N1, CQ = C1_RQ, CK = C1_RK, CV = C1_RV, CG = C1_RG, OUTC = 512; };

__device__ __forceinline__ float logsigmoid_f(float z) { return fminf(z, 0.f) - __logf(1.f + __expf(-fabsf(z))); }

struct GlaRaw { unsigned qk[8]; float a1[8], a2[8]; h16x8 v[2]; };
template <int MIX, bool NEEDQ>
__device__ __forceinline__ void gla_issue(Frame& F, int b, int head, int n, GlaRaw& R) {
    typedef GlaCfg<MIX> C;
    const h16* Hh = (const h16*)(F.ws + WS_H); const int d = F.lane, w = F.wave;
    const size_t row0 = (size_t)b * SEQ + n * 64 + 8 * w; const int col = head * 64 + d;
#pragma unroll
    for (int i = 0; i < 8; ++i) { const unsigned short* hr = (const unsigned short*)(Hh + (row0 + i) * C::PITCH);
        const unsigned qq = NEEDQ ? (unsigned)hr[C::CQ + col] : 0u, kk = (unsigned)hr[C::CK + col];
        R.qk[i] = qq | (kk << 16);
        if (MIX == 0) R.a1[i] = (float)*(const h16*)(hr + C0_GA + (d & 15));
        if (MIX == 2) { const float* rc = (const float*)(F.ws + WS_ROPE); const int pos = n * 64 + 8 * w + i; R.a1[i] = rc[pos * 32 + (d & 31)]; R.a2[i] = rc[SEQ * 32 + pos * 32 + (d & 31)]; } }
#pragma unroll
    for (int i = 0; i < 2; ++i) { const int id = F.tid + i * NTHR, r = id >> 4, ch = id & 15;
        R.v[i] = *(const h16x8*)(Hh + ((size_t)b * SEQ + n * 64 + r) * C::PITCH + C::CV + head * 128 + ch * 8); }
}
template <int MIX, bool NEEDQ>
__device__ __forceinline__ void gla_prep(Frame& F, int head, const GlaRaw& R, float (&q)[8], float (&k)[8], float (&bb)[8], float& blast, LAS float* part) {
    const Args& A = *F.a; const int d = F.lane, w = F.wave, col = head * 64 + d;
    float la[8];
    if (MIX == 0) {
        float wg[16];
#pragma unroll
        for (int r = 0; r < 16; ++r) wg[r] = A.in[I_GLAWG][r * 256 + col];
        const float bg = A.in[I_GLABG][col];
#pragma unroll
        for (int i = 0; i < 8; ++i) { q[i] = NEEDQ ? (float)__builtin_bit_cast(h16, (unsigned short)(R.qk[i] & 0xffffu)) * 0.125f : 0.f; k[i] = (float)__builtin_bit_cast(h16, (unsigned short)(R.qk[i] >> 16));
            const float gf = R.a1[i]; float z = bg;
#pragma unroll
            for (int r = 0; r < 16; ++r) z += __int_as_float(__builtin_amdgcn_readlane(__float_as_int(gf), r)) * wg[r];
            la[i] = logsigmoid_f(z) * (1.f / 16.f); }
    } else if (MIX == 1) {
        const float g0 = A.in[I_HGAMMA][col], g1 = A.in[I_HGAMMA][256 + col]; const float lb = 1.f / (1.f + __expf(g0 - g1));
#pragma unroll
        for (int i = 0; i < 8; ++i) { q[i] = NEEDQ ? (float)__builtin_bit_cast(h16, (unsigned short)(R.qk[i] & 0xffffu)) : 0.f; const float hf = (float)__builtin_bit_cast(h16, (unsigned short)(R.qk[i] >> 16));
            const float f = lb + (1.f - lb) * __builtin_amdgcn_rcpf(1.f + __expf(-hf)); la[i] = __logf(f); k[i] = 1.f - f; }
    } else {
        const float lg = log1pf(-exp2f(-5.f - (float)head));
#pragma unroll
        for (int i = 0; i < 8; ++i) { const float cs = R.a1[i], sn = R.a2[i];
            const float xq = NEEDQ ? (float)__builtin_bit_cast(h16, (unsigned short)(R.qk[i] & 0xffffu)) : 0.f, xk = (float)__builtin_bit_cast(h16, (unsigned short)(R.qk[i] >> 16));
            const float pq = __shfl_xor(xq, 32), pk = __shfl_xor(xk, 32);
            q[i] = d < 32 ? xq * cs - pq * sn : pq * sn + xq * cs;
            k[i] = (d < 32 ? xk * cs - pk * sn : pk * sn + xk * cs) * 0.125f;
            la[i] = lg; }
    }
    float c = 0.f;
#pragma unroll
    for (int i = 0; i < 8; ++i) { c += la[i]; bb[i] = c; }
    part[w * 64 + d] = c;
    __syncthreads();
    float pre = 0.f, tot = 0.f;
#pragma unroll
    for (int w2 = 0; w2 < 8; ++w2) { const float pv = part[w2 * 64 + d]; tot += pv; if (w2 < w) pre += pv; }
#pragma unroll
    for (int i = 0; i < 8; ++i) bb[i] += pre;
    blast = tot;
}
__device__ __forceinline__ void gla_stage_vt(Frame& F, const GlaRaw& R, LAS h16* Vt_l) {
#pragma unroll
    for (int i = 0; i < 2; ++i) { const int id = F.tid + i * NTHR, r = id >> 4, ch = id & 15;
#pragma unroll
        for (int k2 = 0; k2 < 8; ++k2) Vt_l[(ch * 8 + k2) * GS + (r ^ ((ch & 7) << 3))] = R.v[i][k2]; }
}

template <int MIX>
__device__ __forceinline__ void gla_a_body(Frame& F, int gidx, int head, int n, const GlaRaw& R, h16* UT, float* DV) {
    LAS h16* KT_l = (LAS h16*)F.lds;
    LAS h16* Vt_l = (LAS h16*)(F.lds + 9216);
    LAS float* part = (LAS float*)(F.lds + 27648);
    LAS h16* U_l = (LAS h16*)(F.lds + 29696);
    float q[8], k[8], bb[8], blast;
    __syncthreads();
    gla_prep<MIX, false>(F, head, R, q, k, bb, blast, part);
    { h16x8 kv;
#pragma unroll
      for (int i = 0; i < 8; ++i) kv[i] = (h16)(k[i] * __expf(blast - bb[i]));
      *(LAS h16x8*)(KT_l + F.lane * GS + 8 * F.wave) = kv; }
    gla_stage_vt(F, R, Vt_l);
    if (F.wave == 0) DV[((size_t)gidx * 256 + n) * 64 + F.lane] = __expf(blast);
    __syncthreads();
    const int fr = F.lane & 15, fq = F.lane >> 4, w = F.wave;
    const int vsw = (((16 * w + fr) >> 3) & 7) << 3;
    const h16x8 a0 = *(const LAS h16x8*)(Vt_l + (16 * w + fr) * GS + ((8 * fq) ^ vsw)), a1 = *(const LAS h16x8*)(Vt_l + (16 * w + fr) * GS + ((32 + 8 * fq) ^ vsw));
#pragma unroll
    for (int dt = 0; dt < 4; ++dt) {
        const h16x8 b0 = *(const LAS h16x8*)(KT_l + (16 * dt + fr) * GS + 8 * fq), b1 = *(const LAS h16x8*)(KT_l + (16 * dt + fr) * GS + 32 + 8 * fq);
        f32x4 acc = (f32x4){0.f, 0.f, 0.f, 0.f};
        acc = __builtin_amdgcn_mfma_f32_16x16x32_f16(a0, b0, acc, 0, 0, 0);
        acc = __builtin_amdgcn_mfma_f32_16x16x32_f16(a1, b1, acc, 0, 0, 0);
#pragma unroll
        for (int r = 0; r < 4; ++r) U_l[(16 * w + 4 * fq + r) * GS + 16 * dt + fr] = (h16)acc[r];
    }
    __syncthreads();
    h16* up = UT + ((size_t)gidx * 256 + n) * 8192;
#pragma unroll
    for (int i = 0; i < 2; ++i) { const int id = F.tid + i * NTHR, e = id >> 3, ch = id & 7; *(h16x8*)(up + e * 64 + ch * 8) = *(const LAS h16x8*)(U_l + e * GS + ch * 8); }
}

__device__ __forceinline__ void gla_scan_unit(Frame& F, int u, const h16* UT, const float* DV, h16* ST) {
    const int gidx = u >> 2, e = (u & 3) * 32 + (F.tid >> 4), d4 = (F.tid & 15) * 4;
    const h16* up = UT + (size_t)gidx * 256 * 8192 + e * 64 + d4; h16* sp = ST + (size_t)gidx * 256 * 8192 + e * 64 + d4; const float* dp = DV + (size_t)gidx * 256 * 64 + d4;
    f32x4 S = (f32x4){0.f, 0.f, 0.f, 0.f};
    for (int nb = 0; nb < 256; nb += 8) {
        h16x4 uu[8]; f32x4 dd[8];
#pragma unroll
        for (int j = 0; j < 8; ++j) { uu[j] = *(const h16x4*)(up + (size_t)(nb + j) * 8192); dd[j] = *(const f32x4*)(dp + (nb + j) * 64); }
#pragma unroll
        for (int j = 0; j < 8; ++j) { h16x4 o; o[0] = (h16)S[0]; o[1] = (h16)S[1]; o[2] = (h16)S[2]; o[3] = (h16)S[3]; *(h16x4*)(sp + (size_t)(nb + j) * 8192) = o;
#pragma unroll
            for (int c = 0; c < 4; ++c) S[c] = S[c] * dd[j][c] + (float)uu[j][c]; }
    }
}

struct GlaRawC { h16x8 st[8]; h16x8 g[2]; };
template <int MIX>
__device__ __forceinline__ void gla_issue_c(Frame& F, int gidx, int b, int head, int n, const h16* ST, GlaRawC& R) {
    typedef GlaCfg<MIX> C; const h16* Hh = (const h16*)(F.ws + WS_H);
    const int fr = F.lane & 15, fq = F.lane >> 4, eh = F.wave & 1;
    const h16* sp = ST + ((size_t)gidx * 256 + n) * 8192;
#pragma unroll
    for (int et = 0; et < 4; ++et) { const int e0 = 64 * eh + 16 * et; R.st[2 * et] = *(const h16x8*)(sp + (e0 + fr) * 64 + 8 * fq); R.st[2 * et + 1] = *(const h16x8*)(sp + (e0 + fr) * 64 + 32 + 8 * fq); }
#pragma unroll
    for (int i = 0; i < 2; ++i) { const int id = F.tid + i * NTHR, r = id >> 4, ch = id & 15;
        R.g[i] = *(const h16x8*)(Hh + ((size_t)b * SEQ + n * 64 + r) * C::PITCH + C::CG + head * 128 + ch * 8); }
}
template <int MIX>
__device__ __forceinline__ void gla_c_body(Frame& F, int gidx, int b, int head, int n, const GlaRaw& R, const h16* ST, h16* MX, const float* gw) {
    typedef GlaCfg<MIX> C;
    LAS h16* Qb_l = (LAS h16*)F.lds;
    LAS __bf16* QI_l = (LAS __bf16*)(F.lds + 9216);
    LAS __bf16* KI_l = (LAS __bf16*)(F.lds + 18432);
    LAS h16* P_l = (LAS h16*)(F.lds + 55296);
    LAS h16* Vt_l = (LAS h16*)(F.lds + 64512);
    LAS float* part = (LAS float*)(F.lds + 82944);
    LAS float* rI = (LAS float*)(F.lds + 84992);
    LAS float* stats = (LAS float*)(F.lds + 86016);
    LAS h16* G_l = (LAS h16*)(F.lds + 87040);
    LAS h16* O_l = (LAS h16*)(F.lds + 104448);
    float q[8], k[8], bb[8], blast;
    GlaRawC RC; gla_issue_c<MIX>(F, gidx, b, head, n, ST, RC);
    __syncthreads();
    gla_prep<MIX, true>(F, head, R, q, k, bb, blast, part);
    const int d = F.lane, w = F.wave;
    if ((w & 1) == 0) rI[(w >> 1) * 64 + d] = bb[0];
    { unsigned zz = 0u; asm volatile("" : "+v"(zz)); const u32x4 z4 = (u32x4){zz, zz, zz, zz}; LAS u32x4* pz = (LAS u32x4*)P_l; pz[F.tid] = z4; if (F.tid < 64) pz[512 + F.tid] = z4; }
    gla_stage_vt(F, R, Vt_l);
    __syncthreads();
    { const int I = w >> 1; float r[4];
#pragma unroll
      for (int I2 = 0; I2 < 4; ++I2) r[I2] = rI[I2 * 64 + d];
#pragma unroll
      for (int i = 0; i < 8; ++i) { const int t = 8 * w + i;
          Qb_l[t * GS + d] = (h16)(q[i] * __expf(bb[i]));
          QI_l[t * GS + d] = (__bf16)(q[i] * __expf(bb[i] - r[I]));
#pragma unroll
          for (int I2 = 0; I2 < 4; ++I2) if (I2 >= I) KI_l[(I2 * 64 + t) * GS + d] = (__bf16)(k[i] * __expf(fminf(r[I2] - bb[i], 80.f))); } }
    __syncthreads();
    const int fr = F.lane & 15, fq = F.lane >> 4;
    for (int p = w; p < 10; p += 8) {
        const int I = p >= 6 ? 3 : (p >= 3 ? 2 : (p >= 1 ? 1 : 0)), J = p - (I * (I + 1)) / 2;
        const LAS __bf16* ap = QI_l + (16 * I + fr) * GS + 8 * fq; const LAS __bf16* bp = KI_l + (I * 64 + 16 * J + fr) * GS + 8 * fq;
        f32x4 acc = (f32x4){0.f, 0.f, 0.f, 0.f};
        acc = __builtin_amdgcn_mfma_f32_16x16x32_bf16(*(const LAS b16x8*)ap, *(const LAS b16x8*)bp, acc, 0, 0, 0);
        acc = __builtin_amdgcn_mfma_f32_16x16x32_bf16(*(const LAS b16x8*)(ap + 32), *(const LAS b16x8*)(bp + 32), acc, 0, 0, 0);
#pragma unroll
        for (int r = 0; r < 4; ++r) { const int tl = 4 * fq + r; const float v = (I == J && fr > tl) ? 0.f : acc[r]; P_l[(16 * I + tl) * GS + 16 * J + fr] = (h16)v; }
    }
#pragma unroll
    for (int i = 0; i < 2; ++i) { const int id = F.tid + i * NTHR, r = id >> 4, ch = id & 15; *(LAS h16x8*)(G_l + r * GO + ch * 8) = RC.g[i]; }
    __syncthreads();
    const int tt = w >> 1, eh = w & 1;
    const h16x8 p0 = *(const LAS h16x8*)(P_l + (16 * tt + fr) * GS + 8 * fq), p1 = *(const LAS h16x8*)(P_l + (16 * tt + fr) * GS + 32 + 8 * fq);
    const h16x8 qb0 = *(const LAS h16x8*)(Qb_l + (16 * tt + fr) * GS + 8 * fq), qb1 = *(const LAS h16x8*)(Qb_l + (16 * tt + fr) * GS + 32 + 8 * fq);
    f32x4 o[4]; float s1[4] = {0.f, 0.f, 0.f, 0.f}, s2[4] = {0.f, 0.f, 0.f, 0.f};
#pragma unroll
    for (int et = 0; et < 4; ++et) { const int e0 = 64 * eh + 16 * et;
        const int vsw = (((e0 + fr) >> 3) & 7) << 3;
        const h16x8 v0 = *(const LAS h16x8*)(Vt_l + (e0 + fr) * GS + ((8 * fq) ^ vsw)), v1 = *(const LAS h16x8*)(Vt_l + (e0 + fr) * GS + ((32 + 8 * fq) ^ vsw));
        f32x4 acc = (f32x4){0.f, 0.f, 0.f, 0.f};
        acc = __builtin_amdgcn_mfma_f32_16x16x32_f16(p0, v0, acc, 0, 0, 0);
        acc = __builtin_amdgcn_mfma_f32_16x16x32_f16(p1, v1, acc, 0, 0, 0);
        acc = __builtin_amdgcn_mfma_f32_16x16x32_f16(qb0, RC.st[2 * et], acc, 0, 0, 0);
        acc = __builtin_amdgcn_mfma_f32_16x16x32_f16(qb1, RC.st[2 * et + 1], acc, 0, 0, 0);
        o[et] = acc;
#pragma unroll
        for (int r = 0; r < 4; ++r) { s1[r] += acc[r]; s2[r] += acc[r] * acc[r]; } }
#pragma unroll
    for (int r = 0; r < 4; ++r) {
#pragma unroll
        for (int x = 1; x < 16; x <<= 1) { s1[r] += __shfl_xor(s1[r], x); s2[r] += __shfl_xor(s2[r], x); }
        if (fr == 0) { const int t = 16 * tt + 4 * fq + r; stats[(t * 2 + eh) * 2] = s1[r]; stats[(t * 2 + eh) * 2 + 1] = s2[r]; } }
    __syncthreads();
#pragma unroll
    for (int r = 0; r < 4; ++r) { const int t = 16 * tt + 4 * fq + r;
        const float a1 = stats[(t * 2) * 2] + stats[(t * 2 + 1) * 2], a2 = stats[(t * 2) * 2 + 1] + stats[(t * 2 + 1) * 2 + 1];
        float mean = 0.f, rstd;
        if (MIX == 2) { mean = a1 * (1.f / 128.f); const float var = fmaxf(a2 * (1.f / 128.f) - mean * mean, 0.f); rstd = 1.f / sqrtf(var + HEAD_EPS); }
        else rstd = 1.f / sqrtf(a2 * (1.f / 128.f) + HEAD_EPS);
#pragma unroll
        for (int et = 0; et < 4; ++et) { const int e = 64 * eh + 16 * et + fr; const float g = (float)G_l[t * GO + e];
            O_l[t * GO + e] = (h16)((o[et][r] - mean) * rstd * gw[head * 128 + e] * pg8::silu_f(g)); } }
    __syncthreads();
#pragma unroll
    for (int i = 0; i < 2; ++i) { const int id = F.tid + i * NTHR, r = id >> 4, ch = id & 15;
        *(h16x8*)(MX + ((size_t)b * SEQ + n * 64 + r) * DM + C::OUTC + head * 128 + ch * 8) = *(const LAS h16x8*)(O_l + r * GO + ch * 8); }
}

template <int MIXA, int MIXB>
__device__ __forceinline__ void gla_a_phase(Frame& F, int first, int step, int count, h16* UT, float* DV) {
    if (first >= count) return;
    GlaRaw cur, nxt;
    { const int gi = first >> 8, n = first & 255, bh = gi & 7; if (gi < 8) gla_issue<MIXA, false>(F, bh >> 2, bh & 3, n, cur); else gla_issue<MIXB, false>(F, bh >> 2, bh & 3, n, cur); }
    for (int u = first; u < count; u += step) {
        const int un = (u + step) < count ? (u + step) : u;
        { const int gi = un >> 8, n = un & 255, bh = gi & 7; if (gi < 8) gla_issue<MIXA, false>(F, bh >> 2, bh & 3, n, nxt); else gla_issue<MIXB, false>(F, bh >> 2, bh & 3, n, nxt); }
        { const int gi = u >> 8, n = u & 255, bh = gi & 7; if (gi < 8) gla_a_body<MIXA>(F, gi, bh & 3, n, cur, UT, DV); else gla_a_body<MIXB>(F, gi, bh & 3, n, cur, UT, DV); }
        cur = nxt;
    }
}
template <int MIXA, int MIXB>
__device__ __forceinline__ void gla_c_phase(Frame& F, int first, int step, int count, const h16* ST, h16* MX, const float* gwA, const float* gwB) {
    if (first >= count) return;
    GlaRaw cur, nxt;
    { const int gi = first >> 8, n = first & 255, bh = gi & 7; if (gi < 8) gla_issue<MIXA, true>(F, bh >> 2, bh & 3, n, cur); else gla_issue<MIXB, true>(F, bh >> 2, bh & 3, n, cur); }
    for (int u = first; u < count; u += step) {
        const int un = (u + step) < count ? (u + step) : u;
        { const int gi = un >> 8, n = un & 255, bh = gi & 7; if (gi < 8) gla_issue<MIXA, true>(F, bh >> 2, bh & 3, n, nxt); else gla_issue<MIXB, true>(F, bh >> 2, bh & 3, n, nxt); }
        { const int gi = u >> 8, n = u & 255, bh = gi & 7; if (gi < 8) gla_c_body<MIXA>(F, gi, bh >> 2, bh & 3, n, cur, ST, MX, gwA); else gla_c_body<MIXB>(F, gi, bh >> 2, bh & 3, n, cur, ST, MX, gwB); }
        cur = nxt;
    }
}

__device__ __forceinline__ void p_xconv_gather(Frame& F) {
    const Args& A = *F.a; unsigned char* ws = F.ws;
    LAS float* scr = (LAS float*)(F.lds + F.wave * 16384);
    LAS int* ps_l = (LAS int*)(F.lds + LDS_X_OFF);
    const int gw = F.vcu * NWAVES + F.wave, NGW = F.G * NWAVES;
    if (F.tid == 0) {
        int acc = 0; int* meta = (int*)(ws + WS_META);
        for (int e = 0; e < 8; ++e) { const int c = (int)__hip_atomic_load(F.ctl + CW_MOECNT + e, RLX_AGENT); ps_l[e] = acc;
            if (blockIdx.x == 0) { meta[e] = c; meta[8 + e] = acc; const int np = (c + 255) >> 8; for (int p = 0; p < np; ++p) meta[32 + (acc >> 8) + p] = e; }
            acc += ((c + 255) >> 8) << 8; }
        if (blockIdx.x == 0) meta[16] = acc >> 8;
    }
    __syncthreads();
    { const h16* xa = (const h16*)(ws + WS_XA); h16* xs = (h16*)(ws + WS_XS); int* route = (int*)(ws + WS_ROUTE); int* rowslot = (int*)(ws + WS_ROWSLOT);
      for (int t = gw; t < M; t += NGW) { const int* rr = route + (size_t)t * 8; const int r0 = ps_l[rr[0]] + rr[1], r1 = ps_l[rr[2]] + rr[3];
          const h16x8 a = *(const h16x8*)(xa + (size_t)t * DM + F.lane * 8), b = *(const h16x8*)(xa + (size_t)t * DM + 512 + F.lane * 8);
          *(h16x8*)(xs + (size_t)r0 * DM + F.lane * 8) = a; *(h16x8*)(xs + (size_t)r0 * DM + 512 + F.lane * 8) = b;
          *(h16x8*)(xs + (size_t)r1 * DM + F.lane * 8) = a; *(h16x8*)(xs + (size_t)r1 * DM + 512 + F.lane * 8) = b;
          if (F.lane == 0) { rowslot[r0] = 2 * t; rowslot[r1] = 2 * t + 1; } } }
    constexpr int TI = 1792, NT = 8 * 3 * TI;
    for (int it = gw; it < NT; it += NGW) {
        const int e = it / (3 * TI), r = it % (3 * TI), which = r / TI, item = r % TI;
        if (which == 0) transpose_item(A.in[I_XW1] + (size_t)e * 1024 * FE, FE, (h16*)(ws + WS_E13) + (size_t)e * 7168 * 1024, 1024, 2, scr, item, F.lane);
        else if (which == 1) transpose_item(A.in[I_XW3] + (size_t)e * 1024 * FE, FE, (h16*)(ws + WS_E13) + (size_t)e * 7168 * 1024, 1024, 3, scr, item, F.lane);
        else transpose_item(A.in[I_XW2] + (size_t)e * FE * 1024, 1024, (h16*)(ws + WS_E2) + (size_t)e * 1024 * FE, FE, 0, scr, item, F.lane);
    }
}

constexpr int NPH = 33;
#ifndef MK_PER_PHASE
#define MK_PER_PHASE 0
#endif
#if MK_PER_PHASE
#define PH_LO args.ph_lo
#define PH_HI args.ph_hi
#else
#define PH_LO 0
#define PH_HI NPH
#endif
#ifndef PHMASK
#define PHMASK 0xffffffffffffull
#endif
#define IN(k) (((PHMASK >> ((k) >= 20 && (k) < 30 ? 20 + ((k) & 1) : (k))) & 1ull) && PH_LO <= (k) && (k) < PH_HI)
#ifndef REPMASK
#define REPMASK 0ull
#endif
#define REP(k) ((int)((REPMASK >> ((k) >= 20 && (k) < 30 ? 20 + ((k) & 1) : (k))) & 1ull))
#define SEAM(k) do { if (IN(k) && IN((k) + 1)) xcd_barrier(bar); } while (0)
#define XA ((h16*)(F.ws + WS_XA))
#define XB ((h16*)(F.ws + WS_XB))
#define Hb ((h16*)(F.ws + WS_H))
#define Yb ((h16*)(F.ws + WS_Y))
template <int L>
__device__ __forceinline__ void run_layer(Frame& F, const Args& args, const XcdBarrier& bar) {
    const int cid = (int)blockIdx.x;
        const int p_in = L ? 13 : 1, p_out = L ? 17 : 6, p_lnb = L ? 30 : 10;
#define Xin (L ? XB : XA)
#define Xmid (L ? XA : XB)
#define Xffn (L ? XB : XA)
#define MXb ((h16*)(F.ws + (L ? WS_MIXIN1 : WS_MIXIN0)))
        if (IN(p_in)) for (int rep_ = 0; rep_ <= REP(p_in); ++rep_) { launder(F); __syncthreads(); const int N = L ? N1 : N0;
            pg8::Gemm g{Xin, (const h16*)(F.ws + (L ? WS_WIN1 : WS_WIN0)), 1024}; pg8::StaticOrder S; S.init(M, N, F.G, cid);
            pg8::EpiStoreH E{Hb, N};
            pg8::gemm_phase<pg8::EpiStoreH, pg8::StaticOrder, true>(F.lds, g, S, E); }
        SEAM(p_in);
        if (L == 0) {
            if (IN(2)) for (int rep_ = 0; rep_ <= REP(2); ++rep_) { launder(F); __syncthreads(); for (int u = F.vcu; u < 128; u += F.G) moba_kmean_unit(F, u); gla_a_phase<0, 0>(F, F.vcu, F.G, 2048, (h16*)(F.ws + WS_U0), (float*)(F.ws + WS_DV0)); }
            SEAM(2);
            if (IN(3)) for (int rep_ = 0; rep_ <= REP(3); ++rep_) { launder(F); __syncthreads(); for (int u = F.vcu; u < 32 + 1008; u += F.G) { if (u < 32) gla_scan_unit(F, u, (const h16*)(F.ws + WS_U0), (const float*)(F.ws + WS_DV0), (h16*)(F.ws + WS_ST0)); else if (rep_ == 0) moba_select_unit(F, u - 32); } }
            SEAM(3);
            if (IN(4)) for (int rep_ = 0; rep_ <= REP(4); ++rep_) { launder(F); __syncthreads(); moba_sparse_phase(F); }
            SEAM(4);
            if (IN(5)) for (int rep_ = 0; rep_ <= REP(5); ++rep_) { launder(F); __syncthreads(); for (int u = F.vcu; u < 1024; u += F.G) moba_own_unit(F, u); gla_c_phase<0, 0>(F, F.vcu, F.G, 2048, (const h16*)(F.ws + WS_ST0), MXb, args.in[I_GLAN], args.in[I_GLAN]); }
            SEAM(5);
        } else {
            if (IN(14)) for (int rep_ = 0; rep_ <= REP(14); ++rep_) { launder(F); __syncthreads(); gla_a_phase<1, 2>(F, F.vcu, F.G, 4096, (h16*)(F.ws + WS_U1), (float*)(F.ws + WS_DV1)); }
            SEAM(14);
            if (IN(15)) for (int rep_ = 0; rep_ <= REP(15); ++rep_) { launder(F); __syncthreads(); for (int u = F.vcu; u < 64; u += F.G) gla_scan_unit(F, u, (const h16*)(F.ws + WS_U1), (const float*)(F.ws + WS_DV1), (h16*)(F.ws + WS_ST1)); }
            SEAM(15);
            if (IN(16)) for (int rep_ = 0; rep_ <= REP(16); ++rep_) { launder(F); __syncthreads(); gla_c_phase<1, 2>(F, F.vcu, F.G, 4096, (const h16*)(F.ws + WS_ST1), MXb, args.in[I_HNORM], args.in[I_RNORM]); }
            SEAM(16);
        }
        if (IN(p_out)) for (int rep_ = 0; rep_ <= REP(p_out); ++rep_) { launder(F); __syncthreads(); pg8::Gemm g{MXb, (const h16*)(F.ws + (L ? WS_WOUT1 : WS_WOUT0)), 1024}; pg8::StaticOrder S; S.init(M, 1024, F.G, cid);
            pg8::EpiResid E{Yb, Xin};
            pg8::gemm_phase<pg8::EpiResid, pg8::StaticOrder, true>(F.lds, g, S, E); }
        SEAM(p_out);
        if (IN(p_out + 1)) for (int rep_ = 0; rep_ <= REP(p_out + 1); ++rep_) { launder(F); __syncthreads(); __syncthreads();
            if (L == 0) ln_phase<0>(F, Yb, args.in[I_LMG], args.in[I_LMB], Xmid, nullptr, nullptr);
            else ln_phase<1>(F, Yb, args.in[I_LMG] + 1024, args.in[I_LMB] + 1024, Xmid, nullptr, nullptr); }
        SEAM(p_out + 1);
        if (L == 0) {
            if (IN(8)) for (int rep_ = 0; rep_ <= REP(8); ++rep_) { launder(F); __syncthreads(); pg8::Gemm g{Xmid, (const h16*)(F.ws + WS_W13_0), 1024}; pg8::StaticOrder S; S.init(M, 2 * FDP, F.G, cid);
                pg8::EpiSwiGLU E{(h16*)(F.ws + WS_HID), FDP};
                pg8::gemm_phase<pg8::EpiSwiGLU, pg8::StaticOrder, true>(F.lds, g, S, E); }
            SEAM(8);
            if (IN(9)) for (int rep_ = 0; rep_ <= REP(9); ++rep_) { launder(F); __syncthreads(); pg8::Gemm g{(const h16*)(F.ws + WS_HID), (const h16*)(F.ws + WS_W2_0), FDP}; pg8::StaticOrder S; S.init(M, 1024, F.G, cid);
                pg8::EpiResid E{Yb, Xmid};
                pg8::gemm_phase<pg8::EpiResid, pg8::StaticOrder, true>(F.lds, g, S, E); }
            SEAM(9);
        } else {
            if (IN(19)) for (int rep_ = 0; rep_ <= REP(19); ++rep_) { launder(F); __syncthreads(); __syncthreads(); p_xconv_gather(F); }
            SEAM(19);
#define meta ((const int*)(F.ws + WS_META))
#pragma unroll 1
            for (int q = 0; q < MOE_PASSES; ++q) {
                const int pu = 20 + 2 * q;
                if (IN(pu)) for (int rep_ = 0; rep_ <= REP(pu); ++rep_) { launder(F); __syncthreads(); const int PT = __builtin_amdgcn_readfirstlane(meta[16]); const int P0 = MOE_PPP * q, P1 = (P0 + MOE_PPP) < PT ? (P0 + MOE_PPP) : PT;
                    pg8::Gemm g{(const h16*)(F.ws + WS_XS), (const h16*)(F.ws + WS_E13), 1024}; pg8::MoeOrder S; S.init(P0, P1, 28, F.G, cid, 1, meta + 32);
                    pg8::EpiSwiGLU E{(h16*)(F.ws + WS_HQ), FE};
                    pg8::gemm_phase<pg8::EpiSwiGLU, pg8::MoeOrder, true>(F.lds, g, S, E); }
                SEAM(pu);
                if (IN(pu + 1)) for (int rep_ = 0; rep_ <= REP(pu + 1); ++rep_) { launder(F); __syncthreads(); const int PT = __builtin_amdgcn_readfirstlane(meta[16]); const int P0 = MOE_PPP * q, P1 = (P0 + MOE_PPP) < PT ? (P0 + MOE_PPP) : PT;
                    pg8::Gemm g{(const h16*)(F.ws + WS_HQ), (const h16*)(F.ws + WS_E2), FE}; pg8::MoeOrder S; S.init(P0, P1, 4, F.G, cid, 0, meta + 32);
                    pg8::EpiMoeDown E{(h16*)args.out, (const int*)(F.ws + WS_ROWSLOT), meta};
                    pg8::gemm_phase<pg8::EpiMoeDown, pg8::MoeOrder, true>(F.lds, g, S, E); }
                SEAM(pu + 1);
            }
        }
        if (IN(p_lnb)) for (int rep_ = 0; rep_ <= REP(p_lnb); ++rep_) { launder(F); __syncthreads(); __syncthreads();
            if (L == 0) ln_phase<0>(F, Yb, args.in[I_LFG], args.in[I_LFB], Xffn, nullptr, nullptr);
            else ln_phase<2>(F, nullptr, args.in[I_LFG] + 1024, args.in[I_LFB] + 1024, Xffn, Xmid, (const h16*)args.out); }
        SEAM(p_lnb);
        if (IN(p_lnb + 1)) for (int rep_ = 0; rep_ <= REP(p_lnb + 1); ++rep_) { launder(F); __syncthreads(); pg8::Gemm g{(const h16*)(F.ws + WS_PH) + (size_t)L * M * PLE, (const h16*)(F.ws + (L ? WS_WP1 : WS_WP0)), PLE}; pg8::StaticOrder S; S.init(M, 1024, F.G, cid);
            pg8::EpiStoreH E{(h16*)(F.ws + WS_PP), 1024};
            pg8::gemm_phase<pg8::EpiStoreH, pg8::StaticOrder, true>(F.lds, g, S, E); }
        SEAM(p_lnb + 1);
        if (IN(p_lnb + 2)) for (int rep_ = 0; rep_ <= REP(p_lnb + 2); ++rep_) { launder(F); __syncthreads(); pg8::Gemm g{Xffn, (const h16*)(F.ws + (L ? WS_WG1 : WS_WG0)), 1024}; pg8::StaticOrder S; S.init(M, 1024, F.G, cid);
            pg8::EpiPle E{Xffn, (const h16*)(F.ws + WS_PP), L ? XA : XB, args.out, L};
            pg8::gemm_phase<pg8::EpiPle, pg8::StaticOrder, true>(F.lds, g, S, E); }
        if (L == 0) SEAM(12);
    }
__global__ void __launch_bounds__(NTHR, 2) hyb_fwd(Args args) {
    extern __shared__ __attribute__((aligned(16))) unsigned char lds_raw[];
    Frame F;
    F.lds = (LAS unsigned char*)lds_raw; F.tid = threadIdx.x; F.lane = F.tid & 63; F.wave = __builtin_amdgcn_readfirstlane(F.tid >> 6);
    F.G = gridDim.x; { const int bx = blockIdx.x; F.vcu = (F.G % 8 == 0) ? (bx % 8) * (F.G / 8) + bx / 8 : bx; }
    F.ws = args.ws; F.ctl = (gu32*)(args.ws + WS_CTL); F.a = &args;
    if (F.tid < 64) ((LAS unsigned*)(F.lds + LDSCTL_OFF))[F.tid] = 0u;
    __syncthreads();
    XcdBarrier bar; bar.bar = (unsigned*)(F.ctl + CW_BAR); bar.x = 0; bar.st = (volatile LAS unsigned*)(F.lds + LDSCTL_OFF + 32);
    if (PH_HI - PH_LO > 1) bar = xcd_barrier_post((unsigned*)(F.ctl + CW_BAR), (volatile LAS unsigned*)(F.lds + LDSCTL_OFF + 32));
    const int cid = (int)blockIdx.x;

    if (IN(0)) for (int rep_ = 0; rep_ <= REP(0); ++rep_) { launder(F); __syncthreads(); p_prologue(F); }
    SEAM(0);
    run_layer<0>(F, args, bar);
    run_layer<1>(F, args, bar);
#undef XA
#undef XB
#undef Hb
#undef Yb
#undef Xin
#undef Xmid
#undef Xffn
#undef MXb
#undef meta
#undef IN
#undef SEAM
}

#ifndef MK_PER_PHASE
#define MK_PER_PHASE 0
#endif
extern "C" void kernel_launch(void* const* d_in, const int* in_sizes, int n_in, void* d_out, int out_size, void* d_ws, size_t ws_size, hipStream_t stream) {
    static int grid = 0;
    if (grid == 0) {
        if (n_in != 27 || in_sizes[0] != M * DM || out_size != M * DM || ws_size < WS_END) { fprintf(stderr, "kernel_launch: unexpected shapes (n_in %d, in0 %d, out %d, ws %zu); nothing launched\n", n_in, n_in > 0 ? in_sizes[0] : -1, out_size, ws_size); grid = -1; return; }
        int dev = 0, cus = 0, per_cu = 0;
        if (hipGetDevice(&dev) != hipSuccess || hipDeviceGetAttribute(&cus, hipDeviceAttributeMultiprocessorCount, dev) != hipSuccess) { grid = -1; return; }
        if (hipFuncSetAttribute((const void*)hyb_fwd, hipFuncAttributeMaxDynamicSharedMemorySize, LDS_BYTES) != hipSuccess) { fprintf(stderr, "kernel_launch: hipFuncSetAttribute failed\n"); grid = -1; return; }
        if (hipOccupancyMaxActiveBlocksPerMultiprocessor(&per_cu, (const void*)hyb_fwd, NTHR, LDS_BYTES) != hipSuccess || per_cu < 1) fprintf(stderr, "kernel_launch: occupancy query reports %d\n", per_cu);
        (void)hipGetLastError();
        grid = cus;
    }
    if (grid < 0) return;
    if (hipMemsetAsync((char*)d_ws + WS_CTL, 0, CTL_ZERO_BYTES, stream) != hipSuccess) return;
    Args a{};
    for (int i = 0; i < 27; ++i) a.in[i] = (const float*)d_in[i];
    a.out = (float*)d_out; a.ws = (unsigned char*)d_ws;
#if MK_PER_PHASE
    for (int ph = 0; ph < NPH; ++ph) { a.ph_lo = ph; a.ph_hi = ph + 1; hipLaunchKernelGGL(hyb_fwd, dim3(grid), dim3(NTHR), LDS_BYTES, stream, a); }
#else
    a.ph_lo = 0; a.ph_hi = NPH; hipLaunchKernelGGL(hyb_fwd, dim3(grid), dim3(NTHR), LDS_BYTES, stream, a);
#endif
}
```
